# Optimizing an MI355X kernel written in HIP

```python
import math
import jax
import jax.numpy as jnp
from jax import lax
import numpy as np

D_MODEL = 1024
BATCH = 16
SEQ = 4096
DEPTH = 4

ATTN_HEADS = 8
HEAD_DIM = 64
ATTN_WIDTH = ATTN_HEADS * HEAD_DIM
CONV_WIDTH = D_MODEL - ATTN_WIDTH
CONV_K = 3
ROPE_DIM = HEAD_DIM // 4
ROPE_THETA = 500000.0
DILATED_PAIRS = ((128, 1), (512, 4), (2048, 16))
SSM_GROUP = 16
SSM_GROUPS = D_MODEL // SSM_GROUP
SSM_STATE = 64
D_FF = ((8 * D_MODEL // 3 + 255) // 256) * 256
N_EXPERTS = 8
TOP_K = 2
D_FF_EXPERT = 7 * D_MODEL // 2
RMS_EPS = 1e-6
N_EVEN = (DEPTH + 1) // 2
N_ODD = DEPTH // 2
EVEN_SPLITS = (ATTN_WIDTH, 2 * ATTN_WIDTH, 3 * ATTN_WIDTH,
               3 * ATTN_WIDTH + CONV_WIDTH, 3 * ATTN_WIDTH + 2 * CONV_WIDTH)

kernel_name = 'hybrid_dilated_conv_s5_moe_trunk'


def _rmsnorm_f32(x, g):
    xf = x.astype(jnp.float32)
    return xf * lax.rsqrt(jnp.mean(xf * xf, axis=-1, keepdims=True) + RMS_EPS) * g.astype(jnp.float32)


def _ada_norm(x, g, shift, scale):
    y = _rmsnorm_f32(x, g) * (1.0 + scale[:, None, :].astype(jnp.float32)) + shift[:, None, :].astype(jnp.float32)
    return y.astype(x.dtype)


def _rope_tables(positions, dtype):
    inv = ROPE_THETA ** (-jnp.arange(0, ROPE_DIM, 2, dtype=jnp.float32) / ROPE_DIM)
    ang = positions.astype(jnp.float32)[..., None] * inv
    return jnp.cos(ang)[:, :, None, :].astype(dtype), jnp.sin(ang)[:, :, None, :].astype(dtype)


def _partial_rope(t, cos, sin):
    half = ROPE_DIM // 2
    t1 = t[..., :half]
    t2 = t[..., half:ROPE_DIM]
    return jnp.concatenate([t1 * cos - t2 * sin, t2 * cos + t1 * sin, t[..., ROPE_DIM:]], axis=-1)


def _dilated_branch(q, k, v, window, dil):
    bsz, seq, nh, hd = q.shape
    blk = window // dil
    span = blk * dil
    s_pad = -(-seq // span) * span
    nb = s_pad // span

    def to_blocks(t):
        t = jnp.pad(t, ((0, 0), (0, s_pad - seq), (0, 0), (0, 0)))
        return t.reshape(bsz, nb, blk, dil, nh, hd)

    def with_prev(t):
        prev = jnp.pad(t[:, :-1], ((0, 0), (1, 0), (0, 0), (0, 0), (0, 0), (0, 0)))
        return jnp.concatenate([prev, t], axis=2)

    qb = to_blocks(q)
    kc = with_prev(to_blocks(k))
    vc = with_prev(to_blocks(v)).astype(jnp.float32)
    s = jnp.einsum('bnqrhe,bnkrhe->bnrhqk', qb, kc).astype(jnp.float32)
    qi = jnp.arange(blk)[:, None]
    kj = jnp.arange(2 * blk)[None, :]
    dist = blk + qi - kj
    band = (dist >= 0) & (dist <= window // dil)
    has_prev = (jnp.arange(nb)[:, None, None] > 0) | (kj[None] >= blk)
    mask = band[None] & has_prev
    s = jnp.where(mask[:, None, None], s, -jnp.inf)
    m = jnp.max(s, axis=-1, keepdims=True)
    p = jnp.exp(s - m)
    l = jnp.sum(p, axis=-1)
    o = jnp.einsum('bnrhqk,bnkrhe->bnqrhe', p, vc)
    l_t = jnp.transpose(l, (0, 1, 4, 2, 3))
    lse = jnp.transpose(m[..., 0], (0, 1, 4, 2, 3)) + jnp.log(l_t)
    o = (o / l_t[..., None]).reshape(bsz, s_pad, nh, hd)[:, :seq]
    lse = lse.reshape(bsz, s_pad, nh)[:, :seq]
    return o, lse


def _even_mixer(h, cos, sin, w_in, conv_w, w_out):
    bsz, seq, _ = h.shape
    proj = h @ w_in
    q, k, v, b_gate, c_gate, xin = jnp.split(proj, EVEN_SPLITS, axis=-1)
    q = _partial_rope(q.reshape(bsz, seq, ATTN_HEADS, HEAD_DIM), cos, sin) * (HEAD_DIM ** -0.5)
    k = _partial_rope(k.reshape(bsz, seq, ATTN_HEADS, HEAD_DIM), cos, sin)
    v = v.reshape(bsz, seq, ATTN_HEADS, HEAD_DIM)
    outs, lses = zip(*[_dilated_branch(q, k, v, w, d) for (w, d) in DILATED_PAIRS])
    wts = jax.nn.softmax(jnp.stack(lses, axis=0), axis=0)
    a_out = jnp.sum(wts[..., None] * jnp.stack(outs, axis=0), axis=0)
    a_out = a_out.astype(h.dtype).reshape(bsz, seq, ATTN_WIDTH)
    u = c_gate * xin
    conv = lax.conv_general_dilated(u, conv_w[:, None, :], window_strides=(1,),
                                    padding=((CONV_K - 1, 0),),
                                    dimension_numbers=('NWC', 'WIO', 'NWC'),
                                    feature_group_count=CONV_WIDTH)
    b_out = b_gate * conv
    return jnp.concatenate([a_out, b_out], axis=-1) @ w_out


def _diag_scan(a_re, a_im, b_re, b_im):
    def combine(left, right):
        ar_l, ai_l, br_l, bi_l = left
        ar_r, ai_r, br_r, bi_r = right
        return (ar_r * ar_l - ai_r * ai_l,
                ar_r * ai_l + ai_r * ar_l,
                ar_r * br_l - ai_r * bi_l + br_r,
                ar_r * bi_l + ai_r * br_l + bi_r)
    _, _, x_re, x_im = lax.associative_scan(combine, (a_re, a_im, b_re, b_im), axis=0)
    return x_re, x_im


def _s5_mixer(h, a_re, a_im, log_step, b_re, b_im, c_re, c_im, d_skip, glu_w, glu_b):
    bsz, seq, d = h.shape
    f32 = jnp.float32
    hf = h.astype(f32)
    u = hf.reshape(bsz, seq, SSM_GROUPS, SSM_GROUP)
    a_re = a_re.astype(f32)
    a_im = a_im.astype(f32)
    dt = jnp.exp(log_step.astype(f32))[:, None]
    mag = jnp.exp(a_re * dt)
    abar_re = mag * jnp.cos(a_im * dt)
    abar_im = mag * jnp.sin(a_im * dt)
    den = a_re * a_re + a_im * a_im
    nr = abar_re - 1.0
    f_re = (nr * a_re + abar_im * a_im) / den
    f_im = (abar_im * a_re - nr * a_im) / den
    b_re = b_re.astype(f32)
    b_im = b_im.astype(f32)
    bb_re = f_re[..., None] * b_re - f_im[..., None] * b_im
    bb_im = f_re[..., None] * b_im + f_im[..., None] * b_re
    bu_re = jnp.einsum('gpc,bsgc->bsgp', bb_re, u)
    bu_im = jnp.einsum('gpc,bsgc->bsgp', bb_im, u)
    a_seq_re = jnp.broadcast_to(abar_re, (seq, SSM_GROUPS, SSM_STATE))
    a_seq_im = jnp.broadcast_to(abar_im, (seq, SSM_GROUPS, SSM_STATE))
    x_re, x_im = jax.vmap(_diag_scan, in_axes=(None, None, 0, 0))(a_seq_re, a_seq_im, bu_re, bu_im)
    y = (jnp.einsum('gcp,bsgp->bsgc', c_re.astype(f32), x_re)
         - jnp.einsum('gcp,bsgp->bsgc', c_im.astype(f32), x_im))
    y = y.reshape(bsz, seq, d) + d_skip.astype(f32) * hf
    g = jax.nn.gelu(y).astype(h.dtype)
    val, gate = jnp.split(g @ glu_w + glu_b, 2, axis=-1)
    return val * jax.nn.sigmoid(gate)


def _swiglu(h, w_gate, w_up, w_down):
    return (jax.nn.silu(h @ w_gate) * (h @ w_up)) @ w_down


def _moe_swiglu(h, router_w, router_b, w_gate, w_up, w_down):
    bsz, seq, d = h.shape
    hf = h.reshape(bsz * seq, d)
    logits = (hf @ router_w + router_b).astype(jnp.float32)
    probs = jax.nn.softmax(logits, axis=-1)
    top_p, top_i = lax.top_k(probs, TOP_K)
    top_p = top_p / jnp.sum(top_p, axis=-1, keepdims=True)
    gates = jnp.sum(jax.nn.one_hot(top_i, N_EXPERTS, dtype=jnp.float32) * top_p[..., None], axis=1)
    gates = gates.astype(h.dtype)
    out = jnp.zeros_like(hf)
    for e in range(N_EXPERTS):
        out = out + gates[:, e:e + 1] * _swiglu(hf, w_gate[e], w_up[e], w_down[e])
    return out.reshape(bsz, seq, d)


def setup_inputs(seed: int = 0) -> dict:
    key = jax.random.key(seed)
    ks = jax.random.split(key, 32)
    f32 = jnp.float32
    D = D_MODEL

    def nrm(k, shape, scale):
        return jax.random.normal(k, shape, f32) * scale

    x = nrm(ks[0], (BATCH, SEQ, D), 1.0)
    c = nrm(ks[1], (BATCH, D), 1.0)
    offs = jax.random.randint(ks[2], (BATCH, 1), 0, 1024, dtype=jnp.int32)
    positions = offs + jnp.arange(SEQ, dtype=jnp.int32)[None, :]
    mod_w = nrm(ks[3], (DEPTH, D, 6 * D), D ** -0.5)
    mod_b = nrm(ks[4], (DEPTH, 6 * D), 0.02)
    norm_mix_g = 1.0 + nrm(ks[5], (DEPTH, D), 0.02)
    norm_ffn_g = 1.0 + nrm(ks[6], (DEPTH, D), 0.02)
    ev_w_in = nrm(ks[7], (N_EVEN, D, 3 * ATTN_WIDTH + 3 * CONV_WIDTH), D ** -0.5)
    ev_conv_w = nrm(ks[8], (N_EVEN, CONV_K, CONV_WIDTH), CONV_K ** -0.5)
    ev_w_out = nrm(ks[9], (N_EVEN, D, D), D ** -0.5)
    ffn_w_gate = nrm(ks[10], (N_EVEN, D, D_FF), D ** -0.5)
    ffn_w_up = nrm(ks[11], (N_EVEN, D, D_FF), D ** -0.5)
    ffn_w_down = nrm(ks[12], (N_EVEN, D_FF, D), D_FF ** -0.5)
    n_idx = jnp.arange(SSM_STATE, dtype=f32)
    ssm_a_re = -0.5 + nrm(ks[13], (N_ODD, SSM_GROUPS, SSM_STATE), 0.01)
    ssm_a_im = math.pi * n_idx + nrm(ks[14], (N_ODD, SSM_GROUPS, SSM_STATE), 0.01)
    ssm_log_step = jax.random.uniform(ks[15], (N_ODD, SSM_GROUPS), f32, math.log(1e-3), math.log(1e-1))
    ssm_b_re = nrm(ks[16], (N_ODD, SSM_GROUPS, SSM_STATE, SSM_GROUP), (2 * SSM_GROUP) ** -0.5)
    ssm_b_im = nrm(ks[17], (N_ODD, SSM_GROUPS, SSM_STATE, SSM_GROUP), (2 * SSM_GROUP) ** -0.5)
    ssm_c_re = nrm(ks[18], (N_ODD, SSM_GROUPS, SSM_GROUP, SSM_STATE), SSM_STATE ** -0.5)
    ssm_c_im = nrm(ks[19], (N_ODD, SSM_GROUPS, SSM_GROUP, SSM_STATE), SSM_STATE ** -0.5)
    ssm_d = nrm(ks[20], (N_ODD, D), 1.0)
    glu_w = nrm(ks[21], (N_ODD, D, 2 * D), D ** -0.5)
    glu_b = nrm(ks[22], (N_ODD, 2 * D), 0.02)
    moe_router_w = nrm(ks[23], (N_ODD, D, N_EXPERTS), D ** -0.5)
    moe_router_b = nrm(ks[24], (N_ODD, N_EXPERTS), 0.01)
    moe_w_gate = nrm(ks[25], (N_ODD, N_EXPERTS, D, D_FF_EXPERT), D ** -0.5)
    moe_w_up = nrm(ks[26], (N_ODD, N_EXPERTS, D, D_FF_EXPERT), D ** -0.5)
    moe_w_down = nrm(ks[27], (N_ODD, N_EXPERTS, D_FF_EXPERT, D), D_FF_EXPERT ** -0.5)
    final_norm_g = 1.0 + nrm(ks[28], (D,), 0.02)
    return {'x': x, 'c': c, 'positions': positions, 'mod_w': mod_w, 'mod_b': mod_b,
            'norm_mix_g': norm_mix_g, 'norm_ffn_g': norm_ffn_g,
            'ev_w_in': ev_w_in, 'ev_conv_w': ev_conv_w, 'ev_w_out': ev_w_out,
            'ffn_w_gate': ffn_w_gate, 'ffn_w_up': ffn_w_up, 'ffn_w_down': ffn_w_down,
            'ssm_a_re': ssm_a_re, 'ssm_a_im': ssm_a_im, 'ssm_log_step': ssm_log_step,
            'ssm_b_re': ssm_b_re, 'ssm_b_im': ssm_b_im, 'ssm_c_re': ssm_c_re, 'ssm_c_im': ssm_c_im,
            'ssm_d': ssm_d, 'glu_w': glu_w, 'glu_b': glu_b,
            'moe_router_w': moe_router_w, 'moe_router_b': moe_router_b,
            'moe_w_gate': moe_w_gate, 'moe_w_up': moe_w_up, 'moe_w_down': moe_w_down,
            'final_norm_g': final_norm_g}


def reference(x, c, positions, mod_w, mod_b, norm_mix_g, norm_ffn_g,
              ev_w_in, ev_conv_w, ev_w_out, ffn_w_gate, ffn_w_up, ffn_w_down,
              ssm_a_re, ssm_a_im, ssm_log_step, ssm_b_re, ssm_b_im, ssm_c_re, ssm_c_im,
              ssm_d, glu_w, glu_b, moe_router_w, moe_router_b,
              moe_w_gate, moe_w_up, moe_w_down, final_norm_g):
    cos, sin = _rope_tables(positions, x.dtype)
    cond = jax.nn.silu(c)
    for layer in range(DEPTH):
        mod = cond @ mod_w[layer] + mod_b[layer]
        sh_m, sc_m, g_m, sh_f, sc_f, g_f = jnp.split(mod, 6, axis=-1)
        i = layer // 2
        h = _ada_norm(x, norm_mix_g[layer], sh_m, sc_m)
        if layer % 2 == 0:
            mix = _even_mixer(h, cos, sin, ev_w_in[i], ev_conv_w[i], ev_w_out[i])
        else:
            mix = _s5_mixer(h, ssm_a_re[i], ssm_a_im[i], ssm_log_step[i], ssm_b_re[i], ssm_b_im[i],
                            ssm_c_re[i], ssm_c_im[i], ssm_d[i], glu_w[i], glu_b[i])
        x = x + g_m[:, None, :] * mix
        h = _ada_norm(x, norm_ffn_g[layer], sh_f, sc_f)
        if layer % 2 == 0:
            ff = _swiglu(h, ffn_w_gate[i], ffn_w_up[i], ffn_w_down[i])
        else:
            ff = _moe_swiglu(h, moe_router_w[i], moe_router_b[i], moe_w_gate[i], moe_w_up[i], moe_w_down[i])
        x = x + g_f[:, None, :] * ff
    return _rmsnorm_f32(x, final_norm_g).astype(x.dtype)
```

```cpp
#include <hip/hip_runtime.h>
#include <cstdio>
#include <cstdint>
#include <type_traits>

#define LAS __attribute__((address_space(3)))
#define GAS __attribute__((address_space(1)))
typedef unsigned short bf16_t;
typedef short bf16x8 __attribute__((ext_vector_type(8)));
typedef float f32x4 __attribute__((ext_vector_type(4)));
typedef float f32x2 __attribute__((ext_vector_type(2)));
typedef float f32x16 __attribute__((ext_vector_type(16)));
typedef unsigned u32x4 __attribute__((ext_vector_type(4)));
typedef unsigned u32x2 __attribute__((ext_vector_type(2)));
typedef int i32x4 __attribute__((ext_vector_type(4)));

constexpr int DM = 1024, NB = 16, SEQ = 4096, NTOK = NB * SEQ;
constexpr int NH = 8, HD = 64, AW = 512, CW = 512;
constexpr int DFF = 2816, NE = 8, DFE = 3584;
constexpr int NWIN = 3072;
constexpr int SG = 64, SP = 64, SC = 16, SL = 32;
constexpr int NCHUNK = SEQ / SL;
constexpr int S5ROWS = NB * NCHUNK;
constexpr int S5K = SL * SC + 2 * SP;
constexpr float RMS_EPS = 1e-6f;
constexpr float LOG2E = 1.4426950408889634f;
constexpr float QSCALE = 0.125f * LOG2E;

constexpr size_t MiB = 1u << 20;
constexpr size_t WS_CTL = 0, CTL_ZERO_BYTES = 1 * MiB;
constexpr size_t WS_MOD = 1 * MiB;
constexpr size_t WS_GATEB = WS_MOD + 1536 * 1024;
constexpr size_t WS_ROPE = 3 * MiB;
constexpr size_t WS_LIST = 7 * MiB;
constexpr size_t WS_GATEW = 11 * MiB;
constexpr size_t WS_AL = 15 * MiB;
constexpr size_t WS_SB = WS_AL + 65536;
constexpr size_t WS_SHT = WS_AL + 131072, WS_SCT = WS_AL + 393216;
constexpr int SBF_OFF = 64;
constexpr float QH = 8.0f, WQ = 4.0f;
constexpr size_t WS_SCL = 16 * MiB;
constexpr size_t WS_SHL = 24 * MiB;
constexpr size_t WS_SAT = WS_SHT, WS_SAL = WS_SHL;
constexpr size_t WS_WIN = 28 * MiB;
constexpr size_t WS_WOUT = 40 * MiB;
constexpr size_t WS_WGU = 44 * MiB;
constexpr size_t WS_WDN = 66 * MiB;
constexpr size_t WS_WGLU = 77 * MiB;
constexpr size_t WS_WMGU = 85 * MiB;
constexpr size_t WS_REC = 160 * MiB;
constexpr size_t WS_WMDN = 197 * MiB;
constexpr size_t WS_H = 253 * MiB;
constexpr size_t WS_BIG = 381 * MiB;
constexpr size_t WS_XB = WS_BIG + 520 * MiB;
constexpr size_t WS_END = WS_XB + 128 * MiB;
constexpr size_t BG_Q = 0, BG_K = 64 * MiB, BG_V = 128 * MiB, BG_BG = 192 * MiB, BG_U = 256 * MiB, BG_OB = 320 * MiB  , BG_LSE = 512 * MiB  ;
constexpr size_t HID_SLOT = 232 * MiB;
constexpr size_t BG_HID = 0;
constexpr size_t BG_HG = 0;
constexpr size_t BG_S = 160 * MiB;
constexpr size_t BG_BT2 = 224 * MiB;
constexpr size_t BG_W1T = 264 * MiB;
constexpr int CW_TMO = 0;
constexpr int CW_MOECNT = 64;
constexpr int CW_BAR = 4096;

constexpr int LDSCTL_OFF = 0, LDSCTL_BYTES = 8192, MISC_OFF = LDSCTL_OFF + 320;
constexpr int ROWBUF_OFF = 2048;
constexpr int UTAB_OFF = 6144, UTAB_N = 64;
constexpr int RING_OFF = 8192, RING_BYTES = 131072;
constexpr int LDS_BYTES = 147456;

#define LDS_WAIT() asm volatile("s_waitcnt lgkmcnt(0)" ::: "memory")
#define VM_WAIT() asm volatile("s_waitcnt vmcnt(0)" ::: "memory")
#define RLX_AGENT __ATOMIC_RELAXED, __HIP_MEMORY_SCOPE_AGENT

__device__ __forceinline__ unsigned cvt_pk_bf16(float lo, float hi) { unsigned r; asm volatile("v_cvt_pk_bf16_f32 %0, %1, %2" : "=v"(r) : "v"(lo), "v"(hi)); return r; }
__device__ __forceinline__ float bf_lo(unsigned w) { return __uint_as_float(w << 16); }
__device__ __forceinline__ float bf_hi(unsigned w) { return __uint_as_float(w & 0xffff0000u); }
template <int CTRL> __device__ __forceinline__ float dppf(float v) { return __builtin_bit_cast(float, __builtin_amdgcn_update_dpp(0, __builtin_bit_cast(int, v), CTRL, 0xf, 0xf, false)); }
__device__ __forceinline__ float wave_sum(float v) {
    v += dppf<0xB1>(v); v += dppf<0x4E>(v); v += dppf<0x124>(v); v += dppf<0x128>(v);
    { auto r = __builtin_amdgcn_permlane16_swap(__float_as_uint(v), __float_as_uint(v), false, false); v = __uint_as_float(r[0]) + __uint_as_float(r[1]); }
    { auto r = __builtin_amdgcn_permlane32_swap(__float_as_uint(v), __float_as_uint(v), false, false); v = __uint_as_float(r[0]) + __uint_as_float(r[1]); }
    return v;
}
__device__ __forceinline__ float wave_max(float v) {
    v = fmaxf(v, dppf<0xB1>(v)); v = fmaxf(v, dppf<0x4E>(v)); v = fmaxf(v, dppf<0x124>(v)); v = fmaxf(v, dppf<0x128>(v));
    { auto r = __builtin_amdgcn_permlane16_swap(__float_as_uint(v), __float_as_uint(v), false, false); v = fmaxf(__uint_as_float(r[0]), __uint_as_float(r[1])); }
    { auto r = __builtin_amdgcn_permlane32_swap(__float_as_uint(v), __float_as_uint(v), false, false); v = fmaxf(__uint_as_float(r[0]), __uint_as_float(r[1])); }
    return v;
}
constexpr float Q8N = 256.0f / 32767.0f, Q8H = 128.0f / 32767.0f;
__device__ __forceinline__ unsigned q8hi(float n0, float n1, float n2, float n3) {
    const unsigned a = __builtin_bit_cast(unsigned, __builtin_amdgcn_cvt_pknorm_i16(n0, n1)), b = __builtin_bit_cast(unsigned, __builtin_amdgcn_cvt_pknorm_i16(n2, n3));
    return __builtin_amdgcn_perm(b, a, 0x07050301u);
}
__device__ __forceinline__ unsigned q8pack(float a, float b, float c, float d, float qs) {
    const float qn = qs * Q8N;
    return q8hi(__builtin_fmaf(a, qn, Q8H), __builtin_fmaf(b, qn, Q8H), __builtin_fmaf(c, qn, Q8H), __builtin_fmaf(d, qn, Q8H));
}
__device__ __forceinline__ f32x4 xb_ld4(const bf16_t* p) { const u32x2 w = *(const u32x2*)p; return (f32x4){bf_lo(w.x), bf_hi(w.x), bf_lo(w.y), bf_hi(w.y)}; }
__device__ __forceinline__ void xb_st4(bf16_t* p, const f32x4 v) { u32x2 w; w.x = cvt_pk_bf16(v.x, v.y); w.y = cvt_pk_bf16(v.z, v.w); *(u32x2*)p = w; }
__device__ __forceinline__ float fast_exp2(float x) { return __builtin_amdgcn_exp2f(x); }
__device__ __forceinline__ float fast_rcp(float x) { return __builtin_amdgcn_rcpf(x); }
__device__ __forceinline__ float fast_rsq(float x) { return __builtin_amdgcn_rsqf(x); }
__device__ __forceinline__ float amax3(float m, float a, float b) { float r; asm("v_max3_f32 %0, %1, |%2|, |%3|" : "=v"(r) : "v"(m), "v"(a), "v"(b)); return r; }
__device__ __forceinline__ float sigmoid_f(float x) { return fast_rcp(1.0f + fast_exp2(-x * LOG2E)); }
__device__ __forceinline__ float silu_f(float x) { return x * sigmoid_f(x); }
__device__ __forceinline__ float gelu_tanh_f(float x) {
    const float u = 0.7978845608028654f * (x + 0.044715f * x * x * x);
    return x * sigmoid_f(2.0f * u);
}

__device__ __forceinline__ f32x2 gelu_tanh_2(f32x2 x) {
    constexpr float A = -2.0f * 0.7978845608028654f * LOG2E, B = A * 0.044715f;
    const f32x2 t = x * ((x * x) * (f32x2){B, B} + (f32x2){A, A});
    const f32x2 d = (f32x2){fast_exp2(t.x), fast_exp2(t.y)} + (f32x2){1.0f, 1.0f};
    return x * (f32x2){fast_rcp(d.x), fast_rcp(d.y)};
}

constexpr int PTAB_OFF = LDSCTL_OFF + 512;
enum { P_X = 0, P_C, P_POS, P_MODW, P_MODB, P_NMIX, P_NFFN, P_WIN, P_CONVW, P_WOUT, P_FG, P_FU, P_FD, P_ARE, P_AIM, P_LSTEP, P_BRE, P_BIM, P_CRE, P_CIM, P_SD, P_GLUW, P_GLUB,
       P_RW, P_RB, P_MG, P_MU, P_MD, P_FNG, P_OUT, P_WS };
struct Frame { LAS unsigned char* lds; int tid, lane, wave, G, bx; };
__device__ __forceinline__ Frame fresh(const Frame& F0) { Frame F; F.lds = F0.lds; int t = threadIdx.x; asm volatile("" : "+v"(t)); F.tid = t; F.lane = t & 63; F.wave = __builtin_amdgcn_readfirstlane(t >> 6);
    int g = gridDim.x, b = blockIdx.x; asm volatile("" : "+s"(g), "+s"(b)); F.G = g; F.bx = b; return F; }
__device__ __forceinline__ int opaque_i(int v) { asm volatile("" : "+s"(v)); return v; }
template <class T> __device__ __forceinline__ T* PT(const Frame& F, int i) {
    unsigned z = 0; asm volatile("" : "+v"(z));
    volatile LAS unsigned* t = (volatile LAS unsigned*)(LAS unsigned char*)(uintptr_t)(z + PTAB_OFF) + 2 * i;
    const unsigned lo = __builtin_amdgcn_readfirstlane(t[0]), hi = __builtin_amdgcn_readfirstlane(t[1]);
    return (T*)(GAS T*)(((unsigned long long)hi << 32) | lo);
}
template <class T> __device__ __forceinline__ T* WSP(const Frame& F, size_t off) { return (T*)(GAS T*)(GAS unsigned char*)(PT<unsigned char>(F, P_WS) + off); }

#define XB_TMO      128
#define XB_XCNT(j)  (256  + 64 * (j))
#define XB_XSUB(j)  (1280 + 64 * (j))
#define XB_XGEN(j)  (2304 + 64 * (j))
#define XB_TOP      3328
#define XB_TOPGEN   3392
#define XCD_BAR_WORDS 3456
#define XB_SPIN_CAP (1u << 22)

__device__ __forceinline__ unsigned xb_ld(unsigned* p)              { return __hip_atomic_load(p, __ATOMIC_RELAXED, __HIP_MEMORY_SCOPE_AGENT); }
__device__ __forceinline__ unsigned xb_add(unsigned* p, unsigned v) { return __hip_atomic_fetch_add(p, v, __ATOMIC_RELAXED, __HIP_MEMORY_SCOPE_AGENT); }
__device__ __forceinline__ unsigned xb_xcc_id() { return (unsigned)__builtin_amdgcn_s_getreg((3 << 11) | 20) & 0xFu; }
#define XB_SPIN(cond, bar) do { unsigned _sp = 0; while (cond) { __builtin_amdgcn_s_sleep(1); \
    if ((++_sp & 255u) == 0u) { if (xb_ld(&(bar)[XB_TMO])) break; if (_sp > XB_SPIN_CAP) { atomicAdd(&(bar)[XB_TMO], 1u); break; } } } } while (0)

struct XcdBarrier { unsigned* bar; unsigned x; volatile LAS unsigned* st; };

__device__ __forceinline__ XcdBarrier xcd_barrier_post(unsigned* bar, volatile LAS unsigned* st) {
    XcdBarrier b; b.bar = bar; b.x = xb_xcc_id(); b.st = st;
    if (threadIdx.x == 0) (void)xb_add(&bar[XB_XCNT(b.x)], 1u);
    return b;
}
__device__ __forceinline__ void xcd_barrier_complete(unsigned* bar, unsigned x, unsigned& nloc, unsigned& nx) {
    const unsigned G = gridDim.x * gridDim.y * gridDim.z;
    unsigned sum, cnt, mine, sp = 0u;
    for (;;) {
        sum = 0u; cnt = 0u; mine = 0u;
#pragma unroll
        for (unsigned j = 0; j < 16; ++j) { const unsigned c = xb_ld(&bar[XB_XCNT(j)]); sum += c; cnt += (c > 0u) ? 1u : 0u; mine = (j == x) ? c : mine; }
        if (sum == G) break;
        __builtin_amdgcn_s_sleep(1);
        if ((++sp & 255u) == 0u) { if (xb_ld(&bar[XB_TMO])) break; if (sp > XB_SPIN_CAP) { atomicAdd(&bar[XB_TMO], 1u); break; } }
    }
    nloc = mine > 0u ? mine : 1u; nx = cnt > 0u ? cnt : 1u;
}
__device__ __forceinline__ void xcd_barrier(const XcdBarrier& b) {
    asm volatile("s_waitcnt vmcnt(0)" ::: "memory");
    __syncthreads();
    if (threadIdx.x == 0) {
        unsigned* bar = b.bar;
        __builtin_amdgcn_s_waitcnt(0);
        unsigned nloc = b.st[0], nx = b.st[1];
        if (nloc == 0u) { xcd_barrier_complete(bar, b.x, nloc, nx); b.st[0] = nloc; b.st[1] = nx; }
        const unsigned old = xb_add(&bar[XB_XSUB(b.x)], 1u);
        const unsigned gen = old / nloc;
        if (old + 1u == (gen + 1u) * nloc) {
            __builtin_amdgcn_fence(__ATOMIC_RELEASE, "agent");
            asm volatile("s_waitcnt vmcnt(0)" ::: "memory");
            const unsigned og = xb_add(&bar[XB_TOP], 1u);
            const unsigned tg = og / nx;
            if (og + 1u == (tg + 1u) * nx) xb_add(&bar[XB_TOPGEN], 1u);
            else XB_SPIN(xb_ld(&bar[XB_TOPGEN]) == tg, bar);
            __builtin_amdgcn_fence(__ATOMIC_ACQUIRE, "agent");
            xb_add(&bar[XB_XGEN(b.x)], 1u);
            asm volatile("s_waitcnt vmcnt(0)" ::: "memory");
        } else {
            XB_SPIN(xb_ld(&bar[XB_XGEN(b.x)]) == gen, bar);
            __builtin_amdgcn_fence(__ATOMIC_ACQUIRE, "agent");
            asm volatile("s_waitcnt vmcnt(0)" ::: "memory");
        }
    }
    __syncthreads();
}

namespace pg8 {
constexpr int BM = 256, BK = 64, HALF = 128, HTB = HALF * BK * 2, STAGE_BYTES = 8 * HTB, NXCD = 8, WGM = 8;
__host__ __device__ __forceinline__ int lds_byte(int r, int c) { const int st = (r >> 4) * 2 + (c >> 5), rr = r & 15, cc = c & 31, ob = rr * 64 + cc * 2; return st * 1024 + (ob ^ (((ob >> 9) & 1) << 5)); }
__host__ __device__ __forceinline__ void stage_rc(int b, int& R, int& C) { const int st = b / 1024, sb = b % 1024, swz = sb ^ (((sb >> 9) & 1) << 5); R = (st >> 1) * 16 + swz / 64; C = (st & 1) * 32 + (swz % 64) / 2; }
__host__ __device__ __forceinline__ int perm32(int rho) { const int n = rho >> 4, i = rho & 15; return 8 * (i >> 2) + 4 * n + (i & 3); }

struct Unit { int arow, brow0, brow1, orow, pn, aux, nvalid, eid, par; };

__device__ __forceinline__ void tile_order_L(int Lin, int nM, int nN, int& pm, int& pn) {
    asm volatile("" : "+s"(nM), "+s"(nN));
    const int nwg = nM * nN; int wgid = Lin; { const int q = nwg / NXCD, r = nwg % NXCD, xcd = wgid % NXCD, off = wgid / NXCD; wgid = (xcd < r ? xcd * (q + 1) : r * (q + 1) + (xcd - r) * q) + off; }
    const int nig = WGM * nN, gid = wgid / nig, fm = gid * WGM, gsz = (nM - fm) < WGM ? (nM - fm) : WGM;
    pm = fm + ((wgid % nig) % gsz); pn = (wgid % nig) / gsz;
}
__device__ __forceinline__ bool tile_order(int i, int c, int G, int nM, int nN, int& pm, int& pn) {
    asm volatile("" : "+s"(nM), "+s"(nN));
    const int nwg = nM * nN; const long L = (long)i * G + c; if (L >= nwg) return false;
    int wgid = (int)L; { const int q = nwg / NXCD, r = nwg % NXCD, xcd = wgid % NXCD, off = wgid / NXCD; wgid = (xcd < r ? xcd * (q + 1) : r * (q + 1) + (xcd - r) * q) + off; }
    const int nig = WGM * nN, gid = wgid / nig, fm = gid * WGM, gsz = (nM - fm) < WGM ? (nM - fm) : WGM;
    pm = fm + ((wgid % nig) % gsz); pn = (wgid % nig) / gsz; return true;
}

template <class Sched> __device__ __forceinline__ bool utab_next(const Sched& S, int i, Unit& u) {
    if (i >= UTAB_N) return false;
    unsigned z = 0; asm volatile("" : "+v"(z));
    volatile LAS u32x4* e = (volatile LAS u32x4*)(LAS unsigned char*)(uintptr_t)(z + UTAB_OFF + i * 32);
    const u32x4 q0 = e[0], q1 = e[1];
    const int a = __builtin_amdgcn_readfirstlane((int)q0.x); if (a < 0) return false;
    u.arow = a; u.brow0 = __builtin_amdgcn_readfirstlane((int)q0.y); u.brow1 = __builtin_amdgcn_readfirstlane((int)q0.z); u.orow = __builtin_amdgcn_readfirstlane((int)q0.w); u.pn = __builtin_amdgcn_readfirstlane((int)q1.x);
    u.aux = __builtin_amdgcn_readfirstlane((int)q1.y); u.nvalid = __builtin_amdgcn_readfirstlane((int)q1.z); u.eid = __builtin_amdgcn_readfirstlane((int)q1.w); u.par = 0; return true;
}
template <class T> __device__ __forceinline__ void zero16(T& t0, T& t1, T& t2, T& t3, bf16x8 z) {
    f32x16 r; asm volatile("v_mfma_f32_32x32x16_bf16 %0, %1, %1, 0" : "=v"(r) : "v"(z));
    t0 = __builtin_bit_cast(T, (f32x4){r[0], r[1], r[2], r[3]}); t1 = __builtin_bit_cast(T, (f32x4){r[4], r[5], r[6], r[7]});
    t2 = __builtin_bit_cast(T, (f32x4){r[8], r[9], r[10], r[11]}); t3 = __builtin_bit_cast(T, (f32x4){r[12], r[13], r[14], r[15]});
}
__device__ __forceinline__ bf16x8 zero_frag() { u32x4 z; asm volatile("v_mov_b32 %0, 0\n\tv_mov_b32 %1, 0\n\tv_mov_b32 %2, 0\n\tv_mov_b32 %3, 0" : "=v"(z.x), "=v"(z.y), "=v"(z.z), "=v"(z.w)); return __builtin_bit_cast(bf16x8, z); }
template <bool I8> __device__ __forceinline__ f32x4 mma1(bf16x8 b, bf16x8 a, f32x4 c) { return __builtin_amdgcn_mfma_f32_16x16x32_bf16(b, a, c, 0, 0, 0); }
template <bool I8> __device__ __forceinline__ i32x4 mma1(bf16x8 b, bf16x8 a, i32x4 c) { return __builtin_amdgcn_mfma_i32_16x16x64_i8(__builtin_bit_cast(i32x4, b), __builtin_bit_cast(i32x4, a), c, 0, 0, 0); }
template <class Epi, class Sched, bool GATHER, int LDA, int LDB, int KDIM, bool I8 = false>
__device__ __forceinline__ void gemm_phase(LAS unsigned char* lds, const bf16_t* Ag, const bf16_t* Btg, const Sched& S, const Epi& E, const int* gather) {
    int tid = threadIdx.x; asm volatile("" : "+v"(tid));
    const int wid = __builtin_amdgcn_readfirstlane(tid >> 6), lane = tid & 63, wr = wid >> 2, wc = wid & 3, fr = lane & 15, fq = lane >> 4;
    constexpr int nt = KDIM / BK;
#ifndef PREF_BACK
#define PREF_BACK 6
#endif
    constexpr int PREF_T = (nt - PREF_BACK) > 0 ? (nt - PREF_BACK) : 0;
    static_assert(KDIM % 128 == 0 && nt >= 8, "K");
    unsigned voffA[2], voffB[2], cofs[2]; int Rr[2];
#pragma unroll
    for (int i = 0; i < 2; ++i) { int R, C; stage_rc(tid * 16 + i * 8192, R, C); const int Rb = Epi::PERM ? ((R & ~31) + perm32(R & 31)) : R;
        Rr[i] = R; cofs[i] = (unsigned)C * 2u; voffA[i] = (unsigned)(R * LDA + C) * 2u; voffB[i] = (unsigned)(Rb * LDB + C) * 2u; }
    constexpr size_t kstep = (size_t)(BK * 2);
    constexpr size_t hstepA = (size_t)HALF * LDA * 2;
    constexpr size_t rowA = (size_t)LDA * 2, rowB = (size_t)LDB * 2;
    const unsigned ldsw = (unsigned)wid * 1024u;
    const int aoff = lds_byte(wr * 64 + fr, fq * 8), boff = lds_byte(wc * 32 + fr, fq * 8);
#define PG8_SA(b, h) (((b) * 2 + (h)) * HTB)
#define PG8_SB(b, h) ((4 + (b) * 2 + (h)) * HTB)
#define PG8_STAGE(bufoff, gbase, voff) do { _Pragma("unroll") for (int _i = 0; _i < 2; ++_i) \
        __builtin_amdgcn_global_load_lds((const unsigned*)((const char*)(gbase) + (voff)[_i]), (LAS unsigned*)(lds + (bufoff) + ldsw + _i * 8192), 16, 0, 0); } while (0)
#define PG8_LDA(dst, b, h) do { _Pragma("unroll") for (int m = 0; m < 4; ++m) _Pragma("unroll") for (int k = 0; k < 2; ++k) dst[m][k] = *(const LAS bf16x8*)(lds + PG8_SA(b, h) + aoff + m * 2048 + k * 1024); } while (0)
#define PG8_LDB(dst, b, h) do { _Pragma("unroll") for (int n = 0; n < 2; ++n) _Pragma("unroll") for (int k = 0; k < 2; ++k) dst[n][k] = *(const LAS bf16x8*)(lds + PG8_SB(b, h) + boff + n * 2048 + k * 1024); } while (0)
#define PG8_MMA(ai, bj, At, Bt) do { __builtin_amdgcn_s_setprio(1); _Pragma("unroll") for (int m = 0; m < 4; ++m) _Pragma("unroll") for (int n = 0; n < 2; ++n) _Pragma("unroll") for (int k = 0; k < 2; ++k) \
        acc[ai][bj][m][n] = mma1<I8>(Bt[n][k], At[m][k], acc[ai][bj][m][n]); __builtin_amdgcn_s_setprio(0); } while (0)
#define PG8_WAIT_V(n) asm volatile("s_waitcnt vmcnt(" #n ")" ::: "memory")
#define PG8_WAIT_L(n) asm volatile("s_waitcnt lgkmcnt(" #n ")" ::: "memory")
#define PG8_BAR __builtin_amdgcn_s_barrier()
#define PG8_SCHED __builtin_amdgcn_sched_barrier(0)
#define PG8_STG_A(buf, h, isnext, koff) do { if constexpr (GATHER) { unsigned _v[2] = { (unsigned)((isnext) ? vN[h][0] : vA[h][0]) * (unsigned)rowA + cofs[0], (unsigned)((isnext) ? vN[h][1] : vA[h][1]) * (unsigned)rowA + cofs[1] }; PG8_STAGE(PG8_SA(buf, h), (const char*)Ag + (koff), _v); } \
        else { PG8_STAGE(PG8_SA(buf, h), ((isnext) ? nA : cA) + (size_t)(h) * hstepA + (koff), voffA); } } while (0)
#define PG8_STG_B(buf, h, isnext, koff) PG8_STAGE(PG8_SB(buf, h), ((isnext) ? ((h) ? nB1 : nB0) : ((h) ? cB1 : cB0)) + (koff), voffB)
#define PG8_GLOAD(dst, u) do { _Pragma("unroll") for (int _h = 0; _h < 2; ++_h) _Pragma("unroll") for (int _i = 0; _i < 2; ++_i) \
        { int _r = _h * HALF + Rr[_i]; _r = _r < (u).nvalid ? _r : (u).nvalid - 1; dst[_h][_i] = gather[(u).arow + _r]; } } while (0)
#define PG8_GUSE(v) asm volatile("" :: "v"(v[0][0]), "v"(v[0][1]), "v"(v[1][0]), "v"(v[1][1]))
#define PG8_GLOAD_ASM(dst, u) do { _Pragma("unroll") for (int _h = 0; _h < 2; ++_h) _Pragma("unroll") for (int _i = 0; _i < 2; ++_i) \
        { int _r = _h * HALF + Rr[_i]; _r = _r < (u).nvalid ? _r : (u).nvalid - 1; const int* _p = gather + ((u).arow + _r); asm volatile("global_load_dword %0, %1, off" : "=v"(dst[_h][_i]) : "v"(_p) : "memory"); } } while (0)
#define PG8_ROWPF(src_, par_) do { if constexpr (Epi::ROWPF) { if (wid < 2) { const char* _rs = (const char*)(src_) + wid * 1024 + lane * 16; \
        __builtin_amdgcn_global_load_lds((const unsigned*)_rs, (LAS unsigned*)(lds - RING_OFF + ROWBUF_OFF + ((par_) & 1) * 2048 + wid * 1024), 16, 0, 0); } } } while (0)
    { LAS int* ut = (LAS int*)(lds - RING_OFF + UTAB_OFF);
      if (tid < UTAB_N) { Unit tu; const bool ok = S.next(tid, tu); LAS int* e = ut + tid * 8;
          e[0] = ok ? tu.arow : -1; e[1] = tu.brow0; e[2] = tu.brow1; e[3] = tu.orow; e[4] = tu.pn; e[5] = tu.aux; e[6] = tu.nvalid; e[7] = tu.eid; }
      __syncthreads(); }
#define PG8_NEXT(i_, u_) pg8::utab_next(S, (i_), (u_))
    int ui = 0; bool has_next = false;
    const char *cA, *cB0, *cB1, *nA, *nB0, *nB1;
    int vA[2][2] = {{0, 0}, {0, 0}}, vN[2][2] = {{0, 0}, {0, 0}};
    const char* rsN = nullptr;
    Unit uC, uN;
    { Unit cur; if (!PG8_NEXT(0, cur)) return;
      cA = (const char*)Ag + (size_t)cur.arow * rowA; cB0 = (const char*)Btg + (size_t)cur.brow0 * rowB; cB1 = (const char*)Btg + (size_t)cur.brow1 * rowB;
      nA = cA; nB0 = cB0; nB1 = cB1;
      Unit n1; has_next = PG8_NEXT(1, n1);
      if (has_next) { nA = (const char*)Ag + (size_t)n1.arow * rowA; nB0 = (const char*)Btg + (size_t)n1.brow0 * rowB; nB1 = (const char*)Btg + (size_t)n1.brow1 * rowB; }
      if constexpr (GATHER) { PG8_GLOAD(vA, cur); if (has_next) { PG8_GLOAD(vN, n1); } else { PG8_GLOAD(vN, cur); } PG8_GUSE(vA); PG8_GUSE(vN); }
      if constexpr (Epi::ROWPF) { PG8_ROWPF(E.row_src(cur), 0); rsN = (const char*)E.row_src(has_next ? n1 : cur); }
      uC = cur; uN = has_next ? n1 : cur; }
    typedef typename std::conditional<I8, i32x4, f32x4>::type acc_t;
    acc_t acc[2][2][4][2];
    { const bf16x8 zf = zero_frag();
#pragma unroll
    for (int a = 0; a < 2; ++a)
#pragma unroll
        for (int b = 0; b < 2; ++b)
#pragma unroll
            for (int m = 0; m < 4; m += 2) zero16(acc[a][b][m][0], acc[a][b][m][1], acc[a][b][m + 1][0], acc[a][b][m + 1][1], zf); }
    bf16x8 At[4][2], B0[2][2], B1[2][2];
    PG8_STG_B(0, 0, false, 0); PG8_STG_B(0, 1, false, 0); PG8_STG_A(0, 0, false, 0); PG8_STG_A(0, 1, false, 0);
    PG8_STG_B(1, 0, false, kstep); PG8_STG_A(1, 0, false, kstep); PG8_STG_B(1, 1, false, kstep);
    if (wr == 1) PG8_BAR;
    PG8_WAIT_V(6); PG8_BAR;
    PG8_BAR;
    for (;;) {
        for (int t = 0; t < nt; t += 2) {
            const bool last = (t == nt - 2);
            const size_t k1 = (size_t)(t + 1) * kstep, k2 = last ? 0 : (size_t)(t + 2) * kstep, k3 = k2 + kstep;
            PG8_LDB(B0, 0, 0); PG8_LDB(B1, 0, 1); PG8_SCHED; PG8_LDA(At, 0, 0); PG8_STG_A(1, 1, false, k1);
            PG8_WAIT_V(8); PG8_WAIT_L(0); PG8_BAR; PG8_MMA(0, 0, At, B0); PG8_MMA(0, 1, At, B1); PG8_BAR; PG8_SCHED;
            PG8_LDA(At, 0, 1); PG8_STG_B(0, 0, last, k2); PG8_STG_B(0, 1, last, k2); PG8_STG_A(0, 0, last, k2);
            PG8_WAIT_V(8); PG8_WAIT_L(0); PG8_BAR; PG8_MMA(1, 0, At, B0); PG8_MMA(1, 1, At, B1); PG8_BAR; PG8_SCHED;
            PG8_LDB(B0, 1, 0); PG8_LDB(B1, 1, 1); PG8_SCHED; PG8_LDA(At, 1, 0); PG8_STG_A(0, 1, last, k2);
            PG8_WAIT_V(8); PG8_WAIT_L(0); PG8_BAR; PG8_MMA(0, 0, At, B0); PG8_MMA(0, 1, At, B1); PG8_BAR; PG8_SCHED;
            PG8_LDA(At, 1, 1); PG8_STG_B(1, 0, last, k3); PG8_STG_B(1, 1, last, k3); PG8_STG_A(1, 0, last, k3);
            PG8_WAIT_V(8); PG8_WAIT_L(0); PG8_BAR; PG8_MMA(1, 0, At, B0); PG8_MMA(1, 1, At, B1); PG8_BAR; PG8_SCHED;
        }
        if (wr == 0) PG8_BAR;
        { Unit cur = uC; cur.par = ui & 1; E(acc, cur, wr, wc, fr, fq); }
        if (!has_next) break;
        { const bf16x8 zf = zero_frag();
#pragma unroll
        for (int a = 0; a < 2; ++a)
#pragma unroll
            for (int b = 0; b < 2; ++b)
#pragma unroll
                for (int m = 0; m < 4; m += 2) zero16(acc[a][b][m][0], acc[a][b][m][1], acc[a][b][m + 1][0], acc[a][b][m + 1][1], zf); }
        cA = nA; cB0 = nB0; cB1 = nB1; ++ui; uC = uN;
        PG8_ROWPF(rsN, ui);
        { Unit n1; has_next = PG8_NEXT(ui + 1, n1);
          if (has_next) { nA = (const char*)Ag + (size_t)n1.arow * rowA; nB0 = (const char*)Btg + (size_t)n1.brow0 * rowB; nB1 = (const char*)Btg + (size_t)n1.brow1 * rowB; if constexpr (Epi::ROWPF) rsN = (const char*)E.row_src(n1); uN = n1; }
          if constexpr (GATHER) {
#pragma unroll
            for (int _h = 0; _h < 2; ++_h) { vA[_h][0] = vN[_h][0]; vA[_h][1] = vN[_h][1]; }
            asm volatile("" : "+v"(vA[0][0]), "+v"(vA[0][1]), "+v"(vA[1][0]), "+v"(vA[1][1]));
            if (has_next) { PG8_GLOAD_ASM(vN, n1); } } }
        if (wr == 1) PG8_BAR;
    }
    PG8_WAIT_V(0);
    PG8_BAR;
#undef PG8_NEXT
#undef PG8_SA
#undef PG8_SB
#undef PG8_STAGE
#undef PG8_LDA
#undef PG8_LDB
#undef PG8_MMA
#undef PG8_WAIT_V
#undef PG8_WAIT_L
#undef PG8_BAR
#undef PG8_SCHED
#undef PG8_STG_A
#undef PG8_STG_B
#undef PG8_GLOAD
#undef PG8_GUSE
#undef PG8_ROWPF
#undef PG8_GLOAD_ASM
}
}

using pg8::Unit;
template <int NM, int NN> struct SchedPlain {
    int G, c;
    __device__ __forceinline__ bool next(int i, Unit& u) const { int pm, pn; if (!pg8::tile_order(i, c, G, NM, NN, pm, pn)) return false;
        u.arow = pm * 256; u.orow = pm * 256; u.brow0 = pn * 256; u.brow1 = pn * 256 + 128; u.pn = pn; u.aux = 0; u.nvalid = 256; return true; }
};
template <int NM, int NN, int OFF1> struct SchedPair {
    int G, c;
    __device__ __forceinline__ bool next(int i, Unit& u) const { int pm, pn; if (!pg8::tile_order(i, c, G, NM, NN, pm, pn)) return false;
        u.arow = pm * 256; u.orow = pm * 256; u.brow0 = pn * 128; u.brow1 = OFF1 + pn * 128; u.pn = pn; u.aux = 0; u.nvalid = 256; return true; }
};
struct SchedWin {
    int G, c;
    __device__ __forceinline__ bool next(int i, Unit& u) const { int pm, pn; if (!pg8::tile_order(i, c, G, NTOK / 256, 12, pm, pn)) return false;
        u.arow = pm * 256; u.orow = pm * 256; u.pn = pn; u.aux = 0; u.nvalid = 256;
        if (pn < 8) { u.brow0 = pn * 256; u.brow1 = pn * 256 + 128; } else { u.brow0 = 2048 + (pn - 8) * 128; u.brow1 = 2560 + (pn - 8) * 128; }
        return true; }
};
struct SchedS5A {
    int G, c;
    __device__ __forceinline__ bool next(int i, Unit& u) const { int pm, pn; if (!pg8::tile_order(i, c, G, SG * 8, 1, pm, pn)) return false;
        const int g = pm >> 3; u.arow = pm * 256; u.orow = pm * 256; u.brow0 = g * 256; u.brow1 = g * 256 + 128; u.pn = 0; u.aux = g; u.nvalid = 256; return true; }
};
struct SchedS5B {
    int G, c;
    __device__ __forceinline__ bool next(int i, Unit& u) const { int pm, pn; if (!pg8::tile_order(i, c, G, SG * 8, 2, pm, pn)) return false;
        const int g = pm >> 3; u.arow = pm * 256; u.orow = (pm & 7) * 256; u.brow0 = g * 512 + pn * 256; u.brow1 = u.brow0 + 128; u.pn = pn; u.aux = g; u.nvalid = 256; return true; }
};
constexpr int MOETAB_OFF = LDSCTL_OFF + 768;
__device__ __forceinline__ void moe_table(const Frame& F, const unsigned* gcnt) {
    if (F.tid < 8) ((LAS int*)(F.lds - RING_OFF + MOETAB_OFF))[F.tid] = (int)__hip_atomic_load(gcnt + F.tid, __ATOMIC_RELAXED, __HIP_MEMORY_SCOPE_AGENT);
    __syncthreads();
}
__device__ __forceinline__ int moe_tiles(const unsigned* gcnt) {
    int n = 0;
#pragma unroll
    for (int e = 0; e < 8; ++e) n += ((int)__builtin_amdgcn_readfirstlane((int)__hip_atomic_load(gcnt + e, __ATOMIC_RELAXED, __HIP_MEMORY_SCOPE_AGENT)) + 255) >> 8;
    return n;
}
template <int NN, int MODE> struct SchedMoe {
    int G, c, lbase  ;
    __device__ __forceinline__ bool next(int i, Unit& u) const {
        int cnt[8], nM = 0;
        unsigned z = 0; asm volatile("" : "+v"(z));
        volatile LAS int* tab = (volatile LAS int*)(LAS unsigned char*)(uintptr_t)(z + MOETAB_OFF);
#pragma unroll
        for (int e = 0; e < 8; ++e) { cnt[e] = __builtin_amdgcn_readfirstlane(tab[e]); nM += (cnt[e] + 255) >> 8; }
        int pm, pn, half = 0;
        if (MODE == 0) { if (!pg8::tile_order(i, c, G, nM, NN, pm, pn)) return false; }
        else { const int nwg = nM * NN, fullU = (nwg / G) * G; const int L = i * G + c;
            if (MODE == 1) { if (L >= fullU) return false; pg8::tile_order_L(L, nM, NN, pm, pn); }
            else { if (L >= 2 * (nwg - fullU)) return false; pg8::tile_order_L(fullU + (L >> 1), nM, NN, pm, pn); half = L & 1; } }
        int e = 0, mt = pm, ce = cnt[0];
#pragma unroll
        for (int k = 0; k < 7; ++k) { const int te = (cnt[k] + 255) >> 8; if (e == k && mt >= te) { mt -= te; e = k + 1; ce = cnt[k + 1]; } }
        const int nv = ce - mt * 256; u.nvalid = nv < 256 ? nv : 256; u.aux = lbase + e * NTOK + mt * 256; u.pn = pn; u.orow = pm * 256; u.eid = e;
        if (MODE == 0) { u.arow = u.aux; u.brow0 = e * (2 * DFE) + pn * 128; u.brow1 = u.brow0 + DFE; }
        else if (MODE == 1) { u.arow = pm * 256; u.brow0 = e * DM + pn * 256; u.brow1 = u.brow0 + 128; }
        else { u.arow = pm * 256; u.brow0 = e * DM + pn * 256 + half * 128; u.brow1 = u.brow0; u.pn = pn * 2 + half; }
        return true; }
};

#define EPI_ARGS const f32x4 (&acc)[2][2][4][2], const Unit& u, int wr, int wc, int fr, int fq
template <bool I8> struct EpiWin {
    static constexpr bool PERM = true, ROWPF = false;
    Frame F; int li;
    typedef typename std::conditional<I8, i32x4, f32x4>::type acc_t;
    static __device__ __forceinline__ f32x4 cv(const f32x4 a, float) { return a; }
    static __device__ __forceinline__ f32x4 cv(const i32x4 a, float s) { return (f32x4){(float)a[0], (float)a[1], (float)a[2], (float)a[3]} * s; }
    __device__ __forceinline__ void operator()(const acc_t (&acc)[2][2][4][2], const Unit& u, int wr, int wc, int fr, int fq) const {
        const int pn = u.pn, row0 = u.orow + wr * 64 + fr;
        unsigned char* big = WSP<unsigned char>(F, WS_BIG);
        const float* sat = WSP<const float>(F, WS_SHT); const float sbw = I8 ? WSP<const float>(F, WS_SB)[SBF_OFF + 8 + li] : 1.0f;
#define EW_RS(ai) float rsv[4]; _Pragma("unroll") for (int m = 0; m < 4; ++m) rsv[m] = I8 ? sat[row0 + (ai) * 128 + m * 16] * sbw : 1.0f
        if (pn < 8) {
            bf16_t* base = (bf16_t*)(big + (size_t)(pn >> 1) * (64 * MiB));
            const float* rope = WSP<float>(F, WS_ROPE);
            const int colt = (pn & 1) * 256 + wc * 32 + 8 * fq;
            const bool dorope = (pn < 4) && ((wc & 1) == 0) && (fq < 2);
            const float sc = pn < 2 ? QSCALE : 1.0f;
#pragma unroll
            for (int ai = 0; ai < 2; ++ai) {
                EW_RS(ai);
                f32x4 csv[4], snv[4];
#pragma unroll
                for (int m = 0; m < 4; ++m) { const int row = row0 + ai * 128 + m * 16; csv[m] = (f32x4){1.f, 1.f, 1.f, 1.f}; snv[m] = (f32x4){0.f, 0.f, 0.f, 0.f};
                    if (dorope) { csv[m] = *(const f32x4*)(rope + (size_t)row * 16 + 4 * fq); snv[m] = *(const f32x4*)(rope + (size_t)row * 16 + 8 + 4 * fq); } }
#pragma unroll
                for (int m = 0; m < 4; ++m) { const int row = row0 + ai * 128 + m * 16;
                    const f32x4 cs = csv[m], sn = snv[m];
#pragma unroll
                    for (int bj = 0; bj < 2; ++bj) { const f32x4 a0 = cv(acc[ai][bj][m][0], rsv[m]), a1 = cv(acc[ai][bj][m][1], rsv[m]);
                        const f32x4 v0 = (a0 * cs - a1 * sn) * sc, v1 = (a1 * cs + a0 * sn) * sc;
                        u32x4 w; w.x = cvt_pk_bf16(v0[0], v0[1]); w.y = cvt_pk_bf16(v0[2], v0[3]); w.z = cvt_pk_bf16(v1[0], v1[1]); w.w = cvt_pk_bf16(v1[2], v1[3]);
                        *(u32x4*)(base + (size_t)row * 512 + colt + bj * 128) = w; } } }
        } else {
            bf16_t* U = (bf16_t*)(big + BG_U);
            const int ch0 = (pn - 8) * 128 + wc * 32 + 8 * fq;
#pragma unroll
            for (int ai = 0; ai < 2; ++ai) { EW_RS(ai);
#pragma unroll
                for (int m = 0; m < 4; ++m) { const int row = row0 + ai * 128 + m * 16;
                    const float rs = rsv[m]; const f32x4 v0 = cv(acc[ai][0][m][0], rs) * cv(acc[ai][1][m][0], rs), v1 = cv(acc[ai][0][m][1], rs) * cv(acc[ai][1][m][1], rs);
                    u32x4 w; w.x = cvt_pk_bf16(v0[0], v0[1]); w.y = cvt_pk_bf16(v0[2], v0[3]); w.z = cvt_pk_bf16(v1[0], v1[1]); w.w = cvt_pk_bf16(v1[2], v1[3]);
                    *(u32x4*)(U + (size_t)row * 512 + ch0) = w; } }
        }
#undef EW_RS
    }
};
struct EpiRes {
    static constexpr bool PERM = true, ROWPF = false;
    Frame F; int base_is_x, gate_off, dry;
    __device__ __forceinline__ void operator()(EPI_ARGS) const {
        const int row0 = u.orow + wr * 64 + fr, col0 = u.pn * 256 + wc * 32 + 8 * fq, b = u.orow >> 12;
        bf16_t* out = WSP<bf16_t>(F, WS_XB); const float* xin = PT<const float>(F, P_X); const float* gate = WSP<const float>(F, WS_MOD) + gate_off;
#pragma unroll
        for (int bj = 0; bj < 2; ++bj) {
            const f32x4 g0 = *(const f32x4*)(gate + (size_t)b * 6144 + col0 + bj * 128), g1 = *(const f32x4*)(gate + (size_t)b * 6144 + col0 + bj * 128 + 4);
#pragma unroll
            for (int ai = 0; ai < 2; ++ai) {
                f32x4 bs[4][2];
#pragma unroll
                for (int m = 0; m < 4; ++m) { const size_t off = (size_t)(row0 + ai * 128 + m * 16) * DM + col0 + bj * 128;
                    if (base_is_x) { bs[m][0] = *(const f32x4*)(xin + off); bs[m][1] = *(const f32x4*)(xin + off + 4); }
                    else { const u32x4 w = *(const u32x4*)(out + off); bs[m][0] = (f32x4){bf_lo(w.x), bf_hi(w.x), bf_lo(w.y), bf_hi(w.y)}; bs[m][1] = (f32x4){bf_lo(w.z), bf_hi(w.z), bf_lo(w.w), bf_hi(w.w)}; } }
#pragma unroll
                for (int m = 0; m < 4; ++m) { const size_t off = (size_t)(row0 + ai * 128 + m * 16) * DM + col0 + bj * 128;
                    const f32x4 v0 = bs[m][0] + g0 * acc[ai][bj][m][0], v1 = bs[m][1] + g1 * acc[ai][bj][m][1];
                    u32x4 o; o.x = cvt_pk_bf16(v0.x, v0.y); o.y = cvt_pk_bf16(v0.z, v0.w); o.z = cvt_pk_bf16(v1.x, v1.y); o.w = cvt_pk_bf16(v1.z, v1.w);
                    if (!dry) *(u32x4*)(out + off) = o; }
                asm volatile("" ::: "memory"); } }
    }
};
struct EpiResI8 {
    static constexpr bool PERM = true, ROWPF = false;
    Frame F; int gate_off, li, dry;
    __device__ __forceinline__ void operator()(const i32x4 (&acc)[2][2][4][2], const Unit& u, int wr, int wc, int fr, int fq) const {
        const int row0 = u.orow + wr * 64 + fr, col0 = u.pn * 256 + wc * 32 + 8 * fq, b = u.orow >> 12;
        bf16_t* out = WSP<bf16_t>(F, WS_XB); const float* gate = WSP<const float>(F, WS_MOD) + gate_off; const float* sht = WSP<const float>(F, WS_SHT); const float sbd = WSP<const float>(F, WS_SB)[SBF_OFF + 3 * li + 2];
        f32x4 gv[2][2];
#pragma unroll
        for (int bj = 0; bj < 2; ++bj)
#pragma unroll
            for (int n = 0; n < 2; ++n) gv[bj][n] = *(const f32x4*)(gate + (size_t)b * 6144 + col0 + bj * 128 + n * 4) * sbd;
        float shv[2][4];
#pragma unroll
        for (int ai = 0; ai < 2; ++ai)
#pragma unroll
            for (int m = 0; m < 4; ++m) shv[ai][m] = sht[row0 + ai * 128 + m * 16];
#pragma unroll
        for (int ai = 0; ai < 2; ++ai) {
            u32x4 bs[4][2];
#pragma unroll
            for (int m = 0; m < 4; ++m)
#pragma unroll
                for (int bj = 0; bj < 2; ++bj) bs[m][bj] = *(const u32x4*)(out + (size_t)(row0 + ai * 128 + m * 16) * DM + col0 + bj * 128);
#pragma unroll
            for (int m = 0; m < 4; ++m) { const float sh = shv[ai][m];
#pragma unroll
                for (int bj = 0; bj < 2; ++bj) { const u32x4 w = bs[m][bj]; u32x4 o;
#pragma unroll
                    for (int n = 0; n < 2; ++n) { const f32x4 b4 = (f32x4){bf_lo(w[2 * n]), bf_hi(w[2 * n]), bf_lo(w[2 * n + 1]), bf_hi(w[2 * n + 1])}; const i32x4 a = acc[ai][bj][m][n]; const f32x4 af = (f32x4){(float)a[0], (float)a[1], (float)a[2], (float)a[3]};
                        const f32x4 v = b4 + (gv[bj][n] * sh) * af; o[2 * n] = cvt_pk_bf16(v.x, v.y); o[2 * n + 1] = cvt_pk_bf16(v.z, v.w); }
                    if (!dry) *(u32x4*)(out + (size_t)(row0 + ai * 128 + m * 16) * DM + col0 + bj * 128) = o; } }
            asm volatile("" ::: "memory"); }
    }
};
template <int LDH> struct EpiAct {
    static constexpr bool PERM = true, ROWPF = false;
    Frame F; int dry;
    __device__ __forceinline__ void operator()(EPI_ARGS) const {
        bf16_t* hid = WSP<bf16_t>(F, WS_BIG + BG_HID);
        const int row0 = u.orow + wr * 64 + fr, ch0 = u.pn * 128 + wc * 32 + 8 * fq;
#pragma unroll
        for (int ai = 0; ai < 2; ++ai)
#pragma unroll
            for (int m = 0; m < 4; ++m) { f32x4 v[2];
#pragma unroll
                for (int n = 0; n < 2; ++n) { const f32x4 gt = acc[ai][0][m][n], up = acc[ai][1][m][n];
#pragma unroll
                    for (int j = 0; j < 4; ++j) v[n][j] = silu_f(gt[j]) * up[j]; }
                u32x4 w; w.x = cvt_pk_bf16(v[0][0], v[0][1]); w.y = cvt_pk_bf16(v[0][2], v[0][3]); w.z = cvt_pk_bf16(v[1][0], v[1][1]); w.w = cvt_pk_bf16(v[1][2], v[1][3]);
                if (!dry) *(u32x4*)(hid + (size_t)(row0 + ai * 128 + m * 16) * LDH + ch0) = w; }
    }
};
template <int LDH, bool MOE, bool OUT8> struct EpiActI8 {
    static constexpr bool PERM = true, ROWPF = true;
    Frame F; int dry, li, slot;
    __device__ __forceinline__ const void* row_src(const Unit& u) const { return MOE ? (const void*)(WSP<const f32x2>(F, WS_SCL) + u.aux) : (const void*)(WSP<const f32x2>(F, WS_SCT) + u.orow); }
    __device__ __forceinline__ void operator()(const i32x4 (&acc)[2][2][4][2], const Unit& u, int wr, int wc, int fr, int fq) const {
        signed char* hid = WSP<signed char>(F, WS_BIG + BG_HID) + (size_t)slot * HID_SLOT;
        const LAS f32x2* rowbuf = (const LAS f32x2*)(F.lds - RING_OFF + ROWBUF_OFF + u.par * 2048);
        const int row0 = u.orow + wr * 64 + fr, ch0 = u.pn * 128 + wc * 32 + 8 * fq;
#pragma unroll
        for (int ai = 0; ai < 2; ++ai)
#pragma unroll
            for (int m = 0; m < 4; ++m) { const int r = ai * 128 + wr * 64 + m * 16 + fr; const f32x2 rs = rowbuf[r]; const float sgl = rs.x, cc = OUT8 ? rs.y * Q8N : rs.y, icc = fast_rcp(cc); f32x4 v[2]; const f32x2 q8h2 = (f32x2){Q8H, Q8H};
                const f32x2 sgl2 = (f32x2){sgl, sgl}, icc2 = (f32x2){icc, icc};
#pragma unroll
                for (int n = 0; n < 2; ++n) { const i32x4 gt = acc[ai][0][m][n], up = acc[ai][1][m][n];
#pragma unroll
                    for (int j = 0; j < 4; j += 2) { const f32x2 gi = (f32x2){(float)gt[j], (float)gt[j + 1]}, ui = (f32x2){(float)up[j], (float)up[j + 1]};
                        const f32x2 t = gi * sgl2; const f32x2 d = (f32x2){fast_exp2(t.x), fast_exp2(t.y)} * icc2 + icc2; const f32x2 r = (f32x2){fast_rcp(d.x), fast_rcp(d.y)};
                        const f32x2 o = OUT8 ? (gi * ui) * r + q8h2 : (gi * ui) * r; v[n][j] = o.x; v[n][j + 1] = o.y; } }
                if constexpr (OUT8) { u32x2 w; w.x = q8hi(v[0][0], v[0][1], v[0][2], v[0][3]); w.y = q8hi(v[1][0], v[1][1], v[1][2], v[1][3]);
                    if (!dry) *(u32x2*)(hid + (size_t)(row0 + ai * 128 + m * 16) * LDH + ch0) = w; }
                else { u32x4 w; w.x = cvt_pk_bf16(v[0][0], v[0][1]); w.y = cvt_pk_bf16(v[0][2], v[0][3]); w.z = cvt_pk_bf16(v[1][0], v[1][1]); w.w = cvt_pk_bf16(v[1][2], v[1][3]);
                    if (!dry) *(u32x4*)((bf16_t*)hid + (size_t)(row0 + ai * 128 + m * 16) * LDH + ch0) = w; } }
    }
};
struct EpiS5A {
    static constexpr bool PERM = false, ROWPF = false;
    Frame F;
    __device__ __forceinline__ void operator()(EPI_ARGS) const {
        float* S = WSP<float>(F, WS_BIG + BG_S);
        const int row0 = u.orow + wr * 64 + fr, col0 = wc * 32 + 4 * fq;
#pragma unroll
        for (int ai = 0; ai < 2; ++ai)
#pragma unroll
            for (int m = 0; m < 4; ++m)
#pragma unroll
                for (int n = 0; n < 2; ++n) *(f32x4*)(S + (size_t)(row0 + ai * 128 + m * 16) * 128 + col0 + n * 16) = acc[ai][0][m][n];
    }
};
struct EpiS5B {
    static constexpr bool PERM = true, ROWPF = false;
    Frame F;
    __device__ __forceinline__ void operator()(EPI_ARGS) const {
        bf16_t* gact = WSP<bf16_t>(F, WS_H);
        const int g = u.aux, c0 = 8 * (fq & 1);
        const unsigned colbase = (unsigned)(g * 16 + c0) + (unsigned)(16 * u.pn + 2 * wc + (fq >> 1)) * DM;
#pragma unroll
        for (int ai = 0; ai < 2; ++ai)
#pragma unroll
            for (int m = 0; m < 4; ++m) { const int ridx = u.orow + ai * 128 + wr * 64 + m * 16 + fr; const int b = ridx >> 7, ch = ridx & 127;
                const unsigned tok0 = (unsigned)(b * SEQ + ch * SL);
#pragma unroll
                for (int bj = 0; bj < 2; ++bj) {
                    const f32x4 a0 = acc[ai][bj][m][0], a1 = acc[ai][bj][m][1]; f32x4 v0, v1;
#pragma unroll
                    for (int j = 0; j < 4; j += 2) { const f32x2 g0 = gelu_tanh_2((f32x2){a0[j], a0[j + 1]}), g1 = gelu_tanh_2((f32x2){a1[j], a1[j + 1]}); v0[j] = g0.x; v0[j + 1] = g0.y; v1[j] = g1.x; v1[j + 1] = g1.y; }
                    u32x4 w; w.x = cvt_pk_bf16(v0[0], v0[1]); w.y = cvt_pk_bf16(v0[2], v0[3]); w.z = cvt_pk_bf16(v1[0], v1[1]); w.w = cvt_pk_bf16(v1[2], v1[3]);
                    *(u32x4*)(gact + (size_t)(tok0 * DM + colbase + (unsigned)(8 * bj) * DM)) = w; } }
    }
};
struct EpiGlu {
    static constexpr bool PERM = true, ROWPF = false;
    Frame F; int gate_off, li, dry;
    __device__ __forceinline__ void operator()(EPI_ARGS) const {
        bf16_t* out = WSP<bf16_t>(F, WS_XB); const float* gate = WSP<const float>(F, WS_MOD) + gate_off; const float* bias = PT<const float>(F, P_GLUB) + (size_t)li * 2 * DM;
        const int row0 = u.orow + wr * 64 + fr, ch0 = u.pn * 128 + wc * 32 + 8 * fq, b = u.orow >> 12;
        f32x4 gv[2], bv[2], bg[2];
#pragma unroll
        for (int n = 0; n < 2; ++n) { gv[n] = *(const f32x4*)(gate + (size_t)b * 6144 + ch0 + 4 * n); bv[n] = *(const f32x4*)(bias + ch0 + 4 * n); bg[n] = *(const f32x4*)(bias + DM + ch0 + 4 * n) * (-LOG2E); }
        u32x4 bs[2][4];
#pragma unroll
        for (int ai = 0; ai < 2; ++ai)
#pragma unroll
            for (int m = 0; m < 4; ++m) bs[ai][m] = *(const u32x4*)(out + (size_t)(row0 + ai * 128 + m * 16) * DM + ch0);
#pragma unroll
        for (int ai = 0; ai < 2; ++ai)
#pragma unroll
            for (int m = 0; m < 4; ++m) { const size_t off = (size_t)(row0 + ai * 128 + m * 16) * DM + ch0; const u32x4 w = bs[ai][m]; f32x4 o[2];
#pragma unroll
                for (int n = 0; n < 2; ++n) { const f32x4 va = acc[ai][0][m][n] + bv[n], ga = acc[ai][1][m][n], bl = bg[n]; f32x4 mix;
#pragma unroll
                    for (int j = 0; j < 4; j += 2) { const f32x2 t = (f32x2){ga[j], ga[j + 1]} * (f32x2){-LOG2E, -LOG2E} + (f32x2){bl[j], bl[j + 1]};
                        const f32x2 d = (f32x2){fast_exp2(t.x), fast_exp2(t.y)} + (f32x2){1.0f, 1.0f}; const f32x2 mx = (f32x2){va[j], va[j + 1]} * (f32x2){fast_rcp(d.x), fast_rcp(d.y)}; mix[j] = mx.x; mix[j + 1] = mx.y; }
                    const f32x4 b4 = (f32x4){bf_lo(w[2 * n]), bf_hi(w[2 * n]), bf_lo(w[2 * n + 1]), bf_hi(w[2 * n + 1])}; o[n] = b4 + gv[n] * mix; }
                u32x4 ow; ow.x = cvt_pk_bf16(o[0].x, o[0].y); ow.y = cvt_pk_bf16(o[0].z, o[0].w); ow.z = cvt_pk_bf16(o[1].x, o[1].y); ow.w = cvt_pk_bf16(o[1].z, o[1].w);
                if (!dry) *(u32x4*)(out + off) = ow; }
    }
};
struct EpiMoeDown {
    static constexpr bool PERM = false, ROWPF = false;
    Frame F; int gate_off, dry;
    __device__ __forceinline__ void operator()(EPI_ARGS) const {
        bf16_t* x = WSP<bf16_t>(F, WS_XB); const float* gate = WSP<const float>(F, WS_MOD) + gate_off; const int* list = WSP<const int>(F, WS_LIST); const float* gatew = WSP<const float>(F, WS_GATEW);
        const int col0 = u.pn * 256 + wc * 32 + 4 * fq;
#pragma unroll
        for (int ai = 0; ai < 2; ++ai)
#pragma unroll
            for (int m = 0; m < 4; ++m) { const int r = ai * 128 + wr * 64 + m * 16 + fr;
                if (r < u.nvalid) { const int tok = list[u.aux + r]; const float gw = gatew[u.aux + r]; const int b = tok >> 12; const size_t off = (size_t)tok * DM + col0;
#pragma unroll
                    for (int bj = 0; bj < 2; ++bj)
#pragma unroll
                        for (int n = 0; n < 2; ++n) { const f32x4 gv = *(const f32x4*)(gate + (size_t)b * 6144 + col0 + bj * 128 + n * 16); const f32x4 bs = xb_ld4(x + off + bj * 128 + n * 16);
                            if (!dry) xb_st4(x + off + bj * 128 + n * 16, bs + (gv * gw) * acc[ai][bj][m][n]); } }
                asm volatile("" ::: "memory"); }
    }
};

template <bool HALFU> struct EpiMoeDownI8 {
    static constexpr bool PERM = true, ROWPF = true;
    Frame F; int L, dry;
    __device__ __forceinline__ const void* row_src(const Unit& u) const { return (const void*)(WSP<const f32x2>(F, WS_REC) + u.aux); }
    __device__ __forceinline__ void operator()(const i32x4 (&acc)[2][2][4][2], const Unit& u, int wr, int wc, int fr, int fq) const {
        bf16_t* x = WSP<bf16_t>(F, WS_XB); const bf16_t* gateb = WSP<const bf16_t>(F, WS_GATEB) + (size_t)L * 16 * 1024;
        const float sbd = WSP<const float>(F, WS_SB)[16 + u.eid];
        const LAS f32x2* rowbuf = (const LAS f32x2*)(F.lds - RING_OFF + ROWBUF_OFF + u.par * 2048);
        const int col0 = (HALFU ? u.pn * 128 : u.pn * 256) + wc * 32 + 8 * fq;
        constexpr int NBJ = HALFU ? 1 : 2;
#pragma unroll
        for (int ai = 0; ai < 2; ++ai) {
            int tokv[4]; float cwv[4];
#pragma unroll
            for (int m = 0; m < 4; ++m) { const int r = ai * 128 + wr * 64 + m * 16 + fr; const f32x2 rc = rowbuf[r < u.nvalid ? r : u.nvalid - 1];
                tokv[m] = __float_as_int(rc.x); cwv[m] = rc.y * sbd; }
#pragma unroll
            for (int bj = 0; bj < NBJ; ++bj) {
                u32x4 bs[4], gq[4];
#pragma unroll
                for (int m = 0; m < 4; ++m) { const int tok = tokv[m]; bs[m] = *(const u32x4*)(x + (size_t)tok * DM + col0 + bj * 128); gq[m] = *(const u32x4*)(gateb + (size_t)(tok >> 12) * 1024 + col0 + bj * 128); }
#pragma unroll
                for (int m = 0; m < 4; ++m) { const int r = ai * 128 + wr * 64 + m * 16 + fr; const size_t off = (size_t)tokv[m] * DM + col0 + bj * 128; const float cw = cwv[m];
                    if (r < u.nvalid && !dry) { const u32x4 w = bs[m], g = gq[m]; u32x4 o;
#pragma unroll
                        for (int n = 0; n < 2; ++n) { const f32x4 b4 = (f32x4){bf_lo(w[2 * n]), bf_hi(w[2 * n]), bf_lo(w[2 * n + 1]), bf_hi(w[2 * n + 1])}, g4 = (f32x4){bf_lo(g[2 * n]), bf_hi(g[2 * n]), bf_lo(g[2 * n + 1]), bf_hi(g[2 * n + 1])};
                            const i32x4 a = acc[ai][bj][m][n]; const f32x4 af = (f32x4){(float)a[0], (float)a[1], (float)a[2], (float)a[3]}; const f32x4 v = b4 + (g4 * cw) * af;
                            o[2 * n] = cvt_pk_bf16(v.x, v.y); o[2 * n + 1] = cvt_pk_bf16(v.z, v.w); }
                        *(u32x4*)(x + off) = o; } }
                asm volatile("" ::: "memory"); } }
    }
};

__device__ __forceinline__ void conv_item(const float* W, int K, int N, bf16_t* Wt, int ldt, int row_off, LAS float* scr, int item, int lane, int mode) {
    const int nblk = N / 64, kb = item / nblk, nb = item - kb * nblk, k0 = 64 * kb, n0 = 64 * nb;
    const int kr = lane >> 4, nq = lane & 15;
    int nqd = nq;
    if (mode == 1 && n0 < 1024) nqd = (nq == 1) ? 2 : ((nq == 2) ? 1 : nq);
    f32x4 v[16];
    const float* src = W + (size_t)(k0 + kr) * N + n0 + 4 * nq;
#pragma unroll
    for (int i = 0; i < 16; ++i) v[i] = *(const f32x4*)(src + (size_t)(4 * i) * N);
#pragma unroll
    for (int i = 0; i < 16; ++i) { const int kk = 4 * i + kr; int kd = kk;
        if (mode == 2 && k0 < 512) { const int blk = kk >> 5, d5 = kk & 31; kd = ((d5 >> 2) & 1) * 32 + blk * 16 + (d5 & 3) + 4 * (d5 >> 3); }
        *(LAS f32x4*)(scr + kd * 64 + ((4 * nqd) ^ ((kd >> 3) << 3))) = v[i]; }
    LDS_WAIT(); asm volatile("" ::: "memory");
    const int c = lane & 7;
#pragma unroll
    for (int j = 0; j < 8; ++j) { const int n = (lane >> 3) + 8 * j; const LAS float* sp = scr + (8 * c) * 64 + (n ^ (c << 3));
        u32x4 o; o.x = cvt_pk_bf16(sp[0 * 64], sp[1 * 64]); o.y = cvt_pk_bf16(sp[2 * 64], sp[3 * 64]); o.z = cvt_pk_bf16(sp[4 * 64], sp[5 * 64]); o.w = cvt_pk_bf16(sp[6 * 64], sp[7 * 64]);
        *(u32x4*)(Wt + (size_t)(row_off + n0 + n) * ldt + k0 + 8 * c) = o; }
    LDS_WAIT(); asm volatile("" ::: "memory");
}

template <int Q8, bool XF32> __device__ __forceinline__ void norm_plain(const Frame& F, const void* xv, const float* ng, const float* mod_sh, const float* mod_sc, bf16_t* H, float* SAT, float* SHT, const float* sbf) {
    const int gw = F.bx * 8 + F.wave, NGW = F.G * 8;
    for (int rb = gw; rb < NTOK / 32; rb += NGW) {
        const int b = rb >> 7;
        f32x4 gs[4], sh[4];
#pragma unroll
        for (int j = 0; j < 4; ++j) { const int col = 256 * j + 4 * F.lane; const f32x4 g4 = *(const f32x4*)(ng + col), s4 = *(const f32x4*)(mod_sc + (size_t)b * 6144 + col);
            gs[j] = g4 * (s4 + 1.0f); sh[j] = *(const f32x4*)(mod_sh + (size_t)b * 6144 + col); }
        const float* x = (const float*)xv; const bf16_t* xb = (const bf16_t*)xv;
        f32x4 nx[2][4];
        { const size_t e0 = (size_t)rb * 32 * DM + 4 * F.lane;
#pragma unroll
          for (int q = 0; q < 2; ++q)
#pragma unroll
              for (int j = 0; j < 4; ++j) nx[q][j] = XF32 ? *(const f32x4*)(x + e0 + q * DM + 256 * j) : xb_ld4(xb + e0 + q * DM + 256 * j); }
#pragma unroll 2
        for (int rr = 0; rr < 32; rr += 2) { const size_t row = (size_t)rb * 32 + rr;
            f32x4 v[2][4]; float ss[2] = {0.f, 0.f};
#pragma unroll
            for (int q = 0; q < 2; ++q)
#pragma unroll
                for (int j = 0; j < 4; ++j) v[q][j] = nx[q][j];
            if (rr + 2 < 32) { const size_t e0 = (row + 2) * DM + 4 * F.lane;
#pragma unroll
                for (int q = 0; q < 2; ++q)
#pragma unroll
                    for (int j = 0; j < 4; ++j) nx[q][j] = XF32 ? *(const f32x4*)(x + e0 + q * DM + 256 * j) : xb_ld4(xb + e0 + q * DM + 256 * j); }
#pragma unroll
            for (int q = 0; q < 2; ++q)
#pragma unroll
                for (int j = 0; j < 4; ++j) ss[q] += (v[q][j].x * v[q][j].x + v[q][j].y * v[q][j].y) + (v[q][j].z * v[q][j].z + v[q][j].w * v[q][j].w);
#pragma unroll
            for (int q = 0; q < 2; ++q) { const float rstd = fast_rsq(wave_sum(ss[q]) * (1.0f / DM) + RMS_EPS);
                if constexpr (!Q8) { u32x2* o8 = (u32x2*)(H + (row + q) * DM) + F.lane;
#pragma unroll
                    for (int j = 0; j < 4; ++j) { const f32x4 h = v[q][j] * rstd * gs[j] + sh[j]; u32x2 w; w.x = cvt_pk_bf16(h.x, h.y); w.y = cvt_pk_bf16(h.z, h.w); o8[64 * j] = w; }
                } else { float amax = 0.f, hn2 = 0.f;
#pragma unroll
                    for (int j = 0; j < 4; ++j) { const f32x4 h = v[q][j] * rstd * gs[j] + sh[j]; v[q][j] = h; amax = amax3(amax3(amax, h.x, h.y), h.z, h.w); hn2 += (h.x * h.x + h.y * h.y) + (h.z * h.z + h.w * h.w); }
                    amax = wave_max(amax);
                    hn2 = wave_sum(hn2);
                    const float qs = amax > 0.f ? 127.0f * fast_rcp(amax) : 0.f; unsigned* q8 = (unsigned*)((signed char*)H + (row + q) * DM) + F.lane;
#pragma unroll
                    for (int j = 0; j < 4; ++j) __builtin_nontemporal_store(q8pack(v[q][j].x, v[q][j].y, v[q][j].z, v[q][j].w, qs), q8 + 64 * j);
                    if constexpr (Q8 == 2) { if (F.lane == 0) SHT[row + q] = amax * (1.0f / 127.0f); }
                    else if (F.lane == 0) { const float sa_ = amax * (1.0f / 127.0f), sht_ = fmaxf(QH * hn2 * (sbf[0] * (127.0f / WQ)) * (sbf[1] * (127.0f / WQ)), 1e-20f) * (1.0f / 127.0f), sg = sa_ * sbf[0], su = sa_ * sbf[1];
                        SHT[row + q] = sht_; ((f32x2*)SAT)[row + q] = (f32x2){-sg * LOG2E, sg * su / sht_}; } } } }
    }
}
__device__ __forceinline__ void norm_s5(const Frame& F, const bf16_t* x, const float* ng, const float* mod_sh, const float* mod_sc, bf16_t* HG) {
    const int gw = F.bx * 8 + F.wave, NGW = F.G * 8, lane = F.lane;
    LAS unsigned char* scr = F.lds + F.wave * 16384;
    for (int rb = gw; rb < NTOK / 32; rb += NGW) {
        const int b = rb >> 7, chunk = rb & 127;
        f32x4 gs[4], sh[4];
#pragma unroll
        for (int j = 0; j < 4; ++j) { const int col = 16 * lane + 4 * j; const f32x4 g4 = *(const f32x4*)(ng + col), s4 = *(const f32x4*)(mod_sc + (size_t)b * 6144 + col);
            gs[j] = g4 * (s4 + 1.0f); sh[j] = *(const f32x4*)(mod_sh + (size_t)b * 6144 + col); }
        u32x4 nx[2][2];
#pragma unroll
        for (int q = 0; q < 2; ++q)
#pragma unroll
            for (int j = 0; j < 2; ++j) nx[q][j] = *(const u32x4*)(x + ((size_t)rb * 32 + q) * DM + 16 * lane + 8 * j);
        for (int r8 = 0; r8 < 4; ++r8) {
#pragma unroll 2
            for (int jt = 0; jt < 8; ++jt) { const int rr = r8 * 8 + jt; const size_t row = (size_t)rb * 32 + rr;
                f32x4 v[4]; float ss = 0.f;
                { const u32x4 a = nx[0][0], c = nx[0][1]; nx[0][0] = nx[1][0]; nx[0][1] = nx[1][1];
                  v[0] = (f32x4){bf_lo(a.x), bf_hi(a.x), bf_lo(a.y), bf_hi(a.y)}; v[1] = (f32x4){bf_lo(a.z), bf_hi(a.z), bf_lo(a.w), bf_hi(a.w)};
                  v[2] = (f32x4){bf_lo(c.x), bf_hi(c.x), bf_lo(c.y), bf_hi(c.y)}; v[3] = (f32x4){bf_lo(c.z), bf_hi(c.z), bf_lo(c.w), bf_hi(c.w)}; }
#pragma unroll
                for (int j = 0; j < 4; ++j) ss += (v[j].x * v[j].x + v[j].y * v[j].y) + (v[j].z * v[j].z + v[j].w * v[j].w);
                if (rr + 2 < 32) {
#pragma unroll
                    for (int j = 0; j < 2; ++j) nx[1][j] = *(const u32x4*)(x + (row + 2) * DM + 16 * lane + 8 * j); }
                const float rstd = fast_rsq(wave_sum(ss) * (1.0f / DM) + RMS_EPS);
                u32x4 w0, w1; f32x4 h;
                h = v[0] * rstd * gs[0] + sh[0]; w0.x = cvt_pk_bf16(h.x, h.y); w0.y = cvt_pk_bf16(h.z, h.w);
                h = v[1] * rstd * gs[1] + sh[1]; w0.z = cvt_pk_bf16(h.x, h.y); w0.w = cvt_pk_bf16(h.z, h.w);
                h = v[2] * rstd * gs[2] + sh[2]; w1.x = cvt_pk_bf16(h.x, h.y); w1.y = cvt_pk_bf16(h.z, h.w);
                h = v[3] * rstd * gs[3] + sh[3]; w1.z = cvt_pk_bf16(h.x, h.y); w1.w = cvt_pk_bf16(h.z, h.w);
                const int key = lane & 15;
                *(LAS u32x4*)(scr + lane * 256 + (((2 * jt) ^ key) << 4)) = w0; *(LAS u32x4*)(scr + lane * 256 + (((2 * jt + 1) ^ key) << 4)) = w1; }
            LDS_WAIT(); asm volatile("" ::: "memory");
            { const int c = lane & 15, rsub = lane >> 4;
#pragma unroll
              for (int q = 0; q < 16; ++q) { const int g = 4 * q + rsub; const u32x4 wv = *(const LAS u32x4*)(scr + g * 256 + ((c ^ (g & 15)) << 4));
                  __builtin_nontemporal_store(wv, (u32x4*)(HG + ((size_t)g * S5ROWS + b * NCHUNK + chunk) * S5K + r8 * 128 + c * 8)); } }
            LDS_WAIT(); asm volatile("" ::: "memory");
        }
    }
}
__device__ __forceinline__ void norm_final(const Frame& F, const bf16_t* x, float* out, const float* ng) {
    const int gw = F.bx * 8 + F.wave, NGW = F.G * 8;
    f32x4 gs[4];
#pragma unroll
    for (int j = 0; j < 4; ++j) gs[j] = *(const f32x4*)(ng + 256 * j + 4 * F.lane);
    f32x4 nx[2][4];
#pragma unroll
    for (int q = 0; q < 2; ++q)
#pragma unroll
        for (int j = 0; j < 4; ++j) nx[q][j] = xb_ld4(x + ((size_t)gw + (size_t)q * NGW) * DM + 256 * j + 4 * F.lane);
    for (size_t row = gw; row < (size_t)NTOK; row += NGW) {
        f32x4* xr = (f32x4*)(out + row * DM) + F.lane; f32x4 v[4]; float ss = 0.f;
#pragma unroll
        for (int j = 0; j < 4; ++j) { v[j] = nx[0][j]; nx[0][j] = nx[1][j]; ss += (v[j].x * v[j].x + v[j].y * v[j].y) + (v[j].z * v[j].z + v[j].w * v[j].w); }
        if (row + 2 * (size_t)NGW < (size_t)NTOK) {
#pragma unroll
            for (int j = 0; j < 4; ++j) nx[1][j] = xb_ld4(x + (row + 2 * (size_t)NGW) * DM + 256 * j + 4 * F.lane); }
        const float rstd = fast_rsq(wave_sum(ss) * (1.0f / DM) + RMS_EPS);
#pragma unroll
        for (int j = 0; j < 4; ++j) xr[64 * j] = v[j] * rstd * gs[j];
    }
}

constexpr int AT_KPITCH = 144, AT_VPITCH = 784, AT_KBYTES = 384 * AT_KPITCH, AT_VBYTES = 64 * AT_VPITCH;
constexpr int AT_UNITS = NB * NH * 48;
__device__ __forceinline__ int crow(int r, int hi) { return (r & 3) + 8 * (r >> 2) + 4 * hi; }
__device__ __forceinline__ float max3f(float a, float b, float c) { float r; asm("v_max3_f32 %0, %1, %2, %3" : "=v"(r) : "v"(a), "v"(b), "v"(c)); return r; }
__device__ __forceinline__ float swap32(float v) { auto r = __builtin_amdgcn_permlane32_swap(__float_as_uint(v), __float_as_uint(v), false, false); return __uint_as_float(__builtin_amdgcn_mbcnt_hi(~0u, __builtin_amdgcn_mbcnt_lo(~0u, 0u)) < 32 ? r[1] : r[0]); }
struct AttnUnitDesc { int b, h, br, dsh, r, nb; };
__device__ __forceinline__ AttnUnitDesc attn_unit_desc(int un) {
    AttnUnitDesc d; const int bh = un / 48, u48 = un - bh * 48, idx = u48 & 15; d.br = u48 >> 4; d.dsh = 2 * d.br;
    d.r = (d.br == 0) ? 0 : ((d.br == 1) ? (idx & 3) : idx); d.nb = (d.br == 0) ? idx : ((d.br == 1) ? (idx >> 2) : 0); d.b = bh >> 3; d.h = bh & 7; return d;
}
__device__ __forceinline__ void attn_phase(const Frame& F, const bf16_t* Qb, const bf16_t* Kb, const bf16_t* Vb, bf16_t* OB, float* LSE) {
    LAS unsigned char* KS = F.lds; LAS unsigned char* VT = F.lds + AT_KBYTES;
    const int tid = F.tid, lane = F.lane, wid = F.wave, r32 = lane & 31, hi = lane >> 5;
    const int per = (AT_UNITS + F.G - 1) / F.G;
    const int u_lo = F.bx * per, u_hi = (u_lo + per < AT_UNITS) ? u_lo + per : AT_UNITS;
    if (u_lo >= u_hi) return;
    const bool xcdmap = (F.G == 256);
    const int xc = F.bx & 7, rk = F.bx >> 3;
#define AT_UNIT(i_) (xcdmap ? ((xc * 16 + 2 * ((i_) / 3)) * 48 + rk + 32 * ((i_) % 3)) : (u_lo + (i_)))
    u32x4 kreg[6], vreg[2][4];
#define AT_LOAD(un_) do { const AttnUnitDesc d_ = attn_unit_desc(un_); const int jb_ = d_.nb * 256 - 128; const size_t tokb_ = (size_t)d_.b * SEQ; \
        _Pragma("unroll") for (int k = 0; k < 6; ++k) { const int c = tid + 512 * k, row = c >> 3, cc = c & 7, j = jb_ + row; kreg[k] = (u32x4){0u, 0u, 0u, 0u}; \
            if (j >= 0) kreg[k] = *(const u32x4*)(Kb + (tokb_ + d_.r + ((size_t)j << d_.dsh)) * AW + d_.h * 64 + cc * 8); } \
        _Pragma("unroll") for (int it = 0; it < 2; ++it) { const int item = tid + 512 * it, kq = item >> 3, dc = item & 7; \
            _Pragma("unroll") for (int e = 0; e < 4; ++e) { const int j = jb_ + 4 * kq + e; vreg[it][e] = (u32x4){0u, 0u, 0u, 0u}; \
                if (item < 768 && j >= 0) vreg[it][e] = *(const u32x4*)(Vb + (tokb_ + d_.r + ((size_t)j << d_.dsh)) * AW + d_.h * 64 + dc * 8); } } \
        } while (0)
    AT_LOAD(AT_UNIT(0));
    for (int ui_ = 0; ui_ < u_hi - u_lo; ++ui_) { const int un = AT_UNIT(ui_);
        const AttnUnitDesc d = attn_unit_desc(un);
        const int br = d.br, nb = d.nb, h = d.h;
        const size_t qtok = (size_t)d.b * SEQ + d.r + ((size_t)(nb * 256 + 32 * wid + r32) << d.dsh);
        bf16x8 qc[4];
#pragma unroll
        for (int d0 = 0; d0 < 4; ++d0) qc[d0] = *(const bf16x8*)(Qb + qtok * AW + h * 64 + 16 * d0 + 8 * hi);
#pragma unroll
        for (int k = 0; k < 6; ++k) { const int c = tid + 512 * k, row = c >> 3, cc = c & 7; *(LAS u32x4*)(KS + row * AT_KPITCH + cc * 16) = kreg[k]; }
#pragma unroll
        for (int it = 0; it < 2; ++it) { const int item = tid + 512 * it, kq = item >> 3, dc = item & 7;
            if (item < 768) { const int g16 = kq >> 2, cq = kq & 3, cperm = ((cq & 1) << 1) | (cq >> 1);
#pragma unroll
                for (int jj = 0; jj < 8; ++jj) { const int w = jj >> 1; unsigned e0 = vreg[it][0][w], e1 = vreg[it][1][w], e2 = vreg[it][2][w], e3 = vreg[it][3][w];
                    u32x2 o;
                    if (jj & 1) { o.x = (e0 >> 16) | (e1 & 0xffff0000u); o.y = (e2 >> 16) | (e3 & 0xffff0000u); }
                    else { o.x = (e0 & 0xffffu) | (e1 << 16); o.y = (e2 & 0xffffu) | (e3 << 16); }
                    *(LAS u32x2*)(VT + (dc * 8 + jj) * AT_VPITCH + g16 * 32 + cperm * 8) = o; } } }
        __syncthreads();
        if (ui_ + 1 < u_hi - u_lo) { AT_LOAD(AT_UNIT(ui_ + 1)); }
        const int kt0 = (nb == 0) ? ((4 - wid) > 0 ? (4 - wid) : 0) : 0;
        int q32 = r32; asm volatile("" : "+v"(q32));
        f32x16 O0, O1, O2;
#pragma unroll
        for (int i = 0; i < 16; ++i) { O0[i] = 0.f; O1[i] = 0.f; O2[i] = 0.f; }
        float mrun = -1e30f;
        const bf16x8 ones = __builtin_bit_cast(bf16x8, (u32x4){0x3f803f80u, 0x3f803f80u, 0x3f803f80u, 0x3f803f80u});
        for (int kt = kt0; kt < 5; ++kt) {
            const int keybase = 32 * (wid + kt);
            const LAS unsigned char* kp = KS + (keybase + r32) * AT_KPITCH + hi * 16;
            f32x16 sc;
#pragma unroll
            for (int i = 0; i < 16; ++i) sc[i] = 0.f;
#pragma unroll
            for (int d0 = 0; d0 < 4; ++d0) { const bf16x8 kf = *(const LAS bf16x8*)(kp + d0 * 32); sc = __builtin_amdgcn_mfma_f32_32x32x16_bf16(kf, qc[d0], sc, 0, 0, 0); }
            if (kt == 0) {
                asm volatile("" ::: "memory");
#pragma unroll
                for (int i = 0; i < 16; ++i) sc[i] = (crow(i, hi) < q32) ? -1e30f : sc[i]; }
            if (kt == 4) {
                asm volatile("" ::: "memory");
#pragma unroll
                for (int i = 0; i < 16; ++i) sc[i] = (crow(i, hi) > q32) ? -1e30f : sc[i]; }
            float mt = max3f(max3f(sc[0], sc[1], sc[2]), sc[3], sc[4]), mt2 = max3f(max3f(sc[5], sc[6], sc[7]), sc[8], sc[9]);
            mt = max3f(mt, sc[10], sc[11]); mt2 = max3f(mt2, sc[12], sc[13]); mt = max3f(mt, sc[14], sc[15]); mt = max3f(mt, mt2, mt2);
            mt = fmaxf(mt, swap32(mt));
            if (__any(mt > mrun + 8.0f)) {
                const float mnew = fmaxf(mrun, mt), alpha = fast_exp2(mrun - mnew); mrun = mnew;
#pragma unroll
                for (int i = 0; i < 16; ++i) { O0[i] *= alpha; O1[i] *= alpha; O2[i] *= alpha; } }
            const f32x2 m2 = (f32x2){mrun, mrun};
#pragma unroll
            for (int i = 0; i < 16; i += 2) { const f32x2 d = (f32x2){sc[i], sc[i + 1]} - m2; const f32x2 e = (f32x2){fast_exp2(d.x), fast_exp2(d.y)}; sc[i] = e.x; sc[i + 1] = e.y; }
#pragma unroll
            for (int s2 = 0; s2 < 2; ++s2) {
                u32x4 pw; pw.x = cvt_pk_bf16(sc[8 * s2 + 0], sc[8 * s2 + 1]); pw.y = cvt_pk_bf16(sc[8 * s2 + 2], sc[8 * s2 + 3]); pw.z = cvt_pk_bf16(sc[8 * s2 + 4], sc[8 * s2 + 5]); pw.w = cvt_pk_bf16(sc[8 * s2 + 6], sc[8 * s2 + 7]);
                const bf16x8 pf = __builtin_bit_cast(bf16x8, pw);
                const int g16 = (keybase >> 4) + s2;
                const bf16x8 v0 = *(const LAS bf16x8*)(VT + r32 * AT_VPITCH + g16 * 32 + hi * 16);
                const bf16x8 v1 = *(const LAS bf16x8*)(VT + (r32 + 32) * AT_VPITCH + g16 * 32 + hi * 16);
                O0 = __builtin_amdgcn_mfma_f32_32x32x16_bf16(v0, pf, O0, 0, 0, 0);
                O1 = __builtin_amdgcn_mfma_f32_32x32x16_bf16(v1, pf, O1, 0, 0, 0);
                O2 = __builtin_amdgcn_mfma_f32_32x32x16_bf16(ones, pf, O2, 0, 0, 0);
            }
        }
        const float lrun = O2[0];
        const float inv = fast_rcp(lrun);
        { LAS unsigned char* ost = F.lds + (AT_KBYTES + AT_VBYTES) + wid * 4096; const int key = r32 & 7;
          u32x4 w;
          w.x = cvt_pk_bf16(O0[0] * inv, O0[1] * inv); w.y = cvt_pk_bf16(O0[2] * inv, O0[3] * inv); w.z = cvt_pk_bf16(O0[4] * inv, O0[5] * inv); w.w = cvt_pk_bf16(O0[6] * inv, O0[7] * inv); *(LAS u32x4*)(ost + r32 * 128 + (((hi * 4 + 0) ^ key) << 4)) = w;
          w.x = cvt_pk_bf16(O0[8] * inv, O0[9] * inv); w.y = cvt_pk_bf16(O0[10] * inv, O0[11] * inv); w.z = cvt_pk_bf16(O0[12] * inv, O0[13] * inv); w.w = cvt_pk_bf16(O0[14] * inv, O0[15] * inv); *(LAS u32x4*)(ost + r32 * 128 + (((hi * 4 + 1) ^ key) << 4)) = w;
          w.x = cvt_pk_bf16(O1[0] * inv, O1[1] * inv); w.y = cvt_pk_bf16(O1[2] * inv, O1[3] * inv); w.z = cvt_pk_bf16(O1[4] * inv, O1[5] * inv); w.w = cvt_pk_bf16(O1[6] * inv, O1[7] * inv); *(LAS u32x4*)(ost + r32 * 128 + (((hi * 4 + 2) ^ key) << 4)) = w;
          w.x = cvt_pk_bf16(O1[8] * inv, O1[9] * inv); w.y = cvt_pk_bf16(O1[10] * inv, O1[11] * inv); w.z = cvt_pk_bf16(O1[12] * inv, O1[13] * inv); w.w = cvt_pk_bf16(O1[14] * inv, O1[15] * inv); *(LAS u32x4*)(ost + r32 * 128 + (((hi * 4 + 3) ^ key) << 4)) = w;
          LDS_WAIT(); asm volatile("" ::: "memory");
          const int c = lane & 7, rsub = lane >> 3;
#pragma unroll
          for (int q = 0; q < 4; ++q) { const int rq = 8 * q + rsub; const u32x4 wv = *(const LAS u32x4*)(ost + rq * 128 + ((c ^ (rq & 7)) << 4));
              const size_t qt = (size_t)d.b * SEQ + d.r + ((size_t)(nb * 256 + 32 * wid + rq) << d.dsh);
              __builtin_nontemporal_store(wv, (u32x4*)(OB + ((size_t)br * NTOK + qt) * AW + h * 64 + c * 8)); }
          LDS_WAIT(); asm volatile("" ::: "memory"); }
        if (hi == 0) LSE[((size_t)br * NTOK + qtok) * NH + h] = mrun + __log2f(lrun);
        __syncthreads();
    }
#undef AT_LOAD
#undef AT_UNIT
}

__device__ __forceinline__ void combine_phase(const Frame& F, const bf16_t* OB, const float* LSE, const bf16_t* BG, const bf16_t* U, const float* convw, bf16_t* CAT) {
    const int gw = F.bx * 8 + F.wave, NGW = F.G * 8, lane = F.lane, ch0 = 8 * lane, head = lane >> 3;
    f32x4 cw[3][2];
#pragma unroll
    for (int j = 0; j < 3; ++j) { cw[j][0] = *(const f32x4*)(convw + j * CW + ch0); cw[j][1] = *(const f32x4*)(convw + j * CW + ch0 + 4); }
    for (int rb = gw; rb < NTOK / 32; rb += NGW) {
        const size_t tok0 = (size_t)rb * 32; const int t0 = (int)(tok0 & (SEQ - 1));
        const u32x4 z = (u32x4){0u, 0u, 0u, 0u};
        u32x4 u1 = (t0 >= 1) ? *(const u32x4*)(U + (tok0 - 1) * CW + ch0) : z, u0 = (t0 >= 2) ? *(const u32x4*)(U + (tok0 - 2) * CW + ch0) : z;
        float nl0, nl1, nl2; u32x4 no0, no1, no2, nu2, nbg;
#define CB_LOAD(tk) do { nl0 = LSE[(0 * (size_t)NTOK + (tk)) * NH + head]; nl1 = LSE[(1 * (size_t)NTOK + (tk)) * NH + head]; nl2 = LSE[(2 * (size_t)NTOK + (tk)) * NH + head]; \
            no0 = *(const u32x4*)(OB + (0 * (size_t)NTOK + (tk)) * AW + ch0); no1 = *(const u32x4*)(OB + (1 * (size_t)NTOK + (tk)) * AW + ch0); no2 = *(const u32x4*)(OB + (2 * (size_t)NTOK + (tk)) * AW + ch0); \
            nu2 = *(const u32x4*)(U + (tk) * CW + ch0); nbg = *(const u32x4*)(BG + (tk) * CW + ch0); } while (0)
        CB_LOAD(tok0);
        for (int rr = 0; rr < 32; ++rr) { const size_t tok = tok0 + rr;
            const float l0 = nl0, l1 = nl1, l2 = nl2; const u32x4 o0 = no0, o1 = no1, o2 = no2, u2 = nu2, bg = nbg;
            if (rr + 1 < 32) { CB_LOAD(tok + 1); }
            const float mx = fmaxf(l0, fmaxf(l1, l2)); float w0 = fast_exp2(l0 - mx), w1 = fast_exp2(l1 - mx), w2 = fast_exp2(l2 - mx); const float inv = 1.0f / (w0 + w1 + w2); w0 *= inv; w1 *= inv; w2 *= inv;
            u32x4 wa;
#pragma unroll
            for (int k = 0; k < 4; ++k) { const float lo = w0 * bf_lo(o0[k]) + w1 * bf_lo(o1[k]) + w2 * bf_lo(o2[k]), hh = w0 * bf_hi(o0[k]) + w1 * bf_hi(o1[k]) + w2 * bf_hi(o2[k]); wa[k] = cvt_pk_bf16(lo, hh); }
            __builtin_nontemporal_store(wa, (u32x4*)(CAT + tok * DM + ch0));
            u32x4 wb;
#pragma unroll
            for (int k = 0; k < 4; ++k) { const int n = k >> 1, j0 = (k & 1) * 2;
                const float lo = bf_lo(bg[k]) * (cw[0][n][j0] * bf_lo(u0[k]) + cw[1][n][j0] * bf_lo(u1[k]) + cw[2][n][j0] * bf_lo(u2[k]));
                const float hh = bf_hi(bg[k]) * (cw[0][n][j0 + 1] * bf_hi(u0[k]) + cw[1][n][j0 + 1] * bf_hi(u1[k]) + cw[2][n][j0 + 1] * bf_hi(u2[k]));
                wb[k] = cvt_pk_bf16(lo, hh); }
            __builtin_nontemporal_store(wb, (u32x4*)(CAT + tok * DM + AW + ch0));
            u0 = u1; u1 = u2; }
#undef CB_LOAD
    }
}

__device__ __forceinline__ void s5_precompute(const Frame& F, int item, const float* a_re, const float* a_im, const float* log_step, const float* b_re, const float* b_im,
                                              const float* c_re, const float* c_im, const float* dsk, bf16_t* Bt2, bf16_t* W1t, float* AL) {
    LAS float* L = (LAS float*)F.lds;
    LAS float* POWr = L; LAS float* POWi = L + 2112; LAS float* BBr = L + 4224; LAS float* BBi = BBr + 1024; LAS float* Cr = BBi + 1024; LAS float* Ci = Cr + 1024; LAS float* Kt = Ci + 1024;
    const int tid = F.tid, g = item >> 2, q = item & 3;
    const float dt = expf(log_step[g]);
    for (int idx = tid; idx < 64 * 33; idx += 512) { const int p = idx / 33, tau = idx - p * 33; const float ar = a_re[g * 64 + p] * dt, ai = a_im[g * 64 + p] * dt;
        const float mag = expf(ar * (float)tau); float sn, cs; sincosf(ai * (float)tau, &sn, &cs); POWr[idx] = mag * cs; POWi[idx] = mag * sn; }
    for (int idx = tid; idx < 1024; idx += 512) { const int p = idx >> 4, c = idx & 15; const float are = a_re[g * 64 + p], aim = a_im[g * 64 + p];
        const float mag = expf(are * dt); float sn, cs; sincosf(aim * dt, &sn, &cs); const float abr = mag * cs, abi = mag * sn, den = are * are + aim * aim, nr = abr - 1.0f;
        const float fre = (nr * are + abi * aim) / den, fim = (abi * are - nr * aim) / den; const float br = b_re[(size_t)(g * 64 + p) * 16 + c], bi = b_im[(size_t)(g * 64 + p) * 16 + c];
        BBr[idx] = fre * br - fim * bi; BBi[idx] = fre * bi + fim * br; }
    for (int idx = tid; idx < 1024; idx += 512) { const int cp = idx >> 6, p = idx & 63; Cr[idx] = c_re[(size_t)(g * 16 + cp) * 64 + p]; Ci[idx] = c_im[(size_t)(g * 16 + cp) * 64 + p]; }
    __syncthreads();
    for (int idx = tid; idx < 2048; idx += 512) { const int tau = idx >> 6, cq = (idx >> 4) & 3, cp = 4 * q + cq, c = idx & 15; float sum = 0.f;
        for (int p = 0; p < 64; ++p) { const float pr = POWr[p * 33 + tau], pi = POWi[p * 33 + tau], br = BBr[p * 16 + c], bi = BBi[p * 16 + c];
            sum += Cr[cp * 64 + p] * (pr * br - pi * bi) - Ci[cp * 64 + p] * (pr * bi + pi * br); }
        if (tau == 0 && cp == c) sum += dsk[g * 16 + c];
        Kt[idx] = sum; }
    __syncthreads();
    for (int qq = tid; qq < 128 * 80; qq += 512) { const int rl = qq / 80, cc = qq - rl * 80, t = rl >> 2, cq = rl & 3, cp = 4 * q + cq, row = t * 16 + cp; float v[8];
        if (cc < 64) { const int s = cc >> 1, c0 = (cc & 1) * 8;
#pragma unroll
            for (int j = 0; j < 8; ++j) v[j] = (s <= t) ? Kt[(t - s) * 64 + cq * 16 + c0 + j] : 0.f;
        } else { const int p0 = (cc - 64) * 4;
#pragma unroll
            for (int j = 0; j < 8; ++j) { const int p = p0 + (j >> 1); const float pr = POWr[p * 33 + t + 1], pi = POWi[p * 33 + t + 1], cr = Cr[cp * 64 + p], ci = Ci[cp * 64 + p];
                v[j] = (j & 1) ? -(cr * pi + ci * pr) : (cr * pr - ci * pi); } }
        u32x4 w; w.x = cvt_pk_bf16(v[0], v[1]); w.y = cvt_pk_bf16(v[2], v[3]); w.z = cvt_pk_bf16(v[4], v[5]); w.w = cvt_pk_bf16(v[6], v[7]);
        *(u32x4*)(Bt2 + ((size_t)g * 512 + row) * S5K + cc * 8) = w; }
    for (int qq = tid; qq < 64 * 64; qq += 512) { const int rl = qq >> 6, cc = qq & 63, s = cc >> 1, c0 = (cc & 1) * 8; float v[8];
        int row;
        if (rl < 32) { row = 32 * q + rl; const int p = row >> 1, im = row & 1; const float pr = POWr[p * 33 + 31 - s], pi = POWi[p * 33 + 31 - s];
#pragma unroll
            for (int j = 0; j < 8; ++j) { const float br = BBr[p * 16 + c0 + j], bi = BBi[p * 16 + c0 + j]; v[j] = im ? (pr * bi + pi * br) : (pr * br - pi * bi); }
        } else { row = 128 + 32 * q + (rl - 32);
#pragma unroll
            for (int j = 0; j < 8; ++j) v[j] = 0.f; }
        u32x4 w; w.x = cvt_pk_bf16(v[0], v[1]); w.y = cvt_pk_bf16(v[2], v[3]); w.z = cvt_pk_bf16(v[4], v[5]); w.w = cvt_pk_bf16(v[6], v[7]);
        *(u32x4*)(W1t + ((size_t)g * 256 + row) * 512 + cc * 8) = w; }
    if (q == 0 && tid < 64) { AL[(g * 64 + tid) * 2] = POWr[tid * 33 + 32]; AL[(g * 64 + tid) * 2 + 1] = POWi[tid * 33 + 32]; }
    __syncthreads();
}
__device__ __forceinline__ void s5_scan(const Frame& F, const float* S, const float* AL, bf16_t* HG) {
    const int gw = F.bx * 8 + F.wave, NGW = F.G * 8, p = F.lane;
    for (int item = gw; item < SG * NB; item += NGW) { const int g = item >> 4, b = item & 15;
        const float ar = AL[(g * 64 + p) * 2], ai = AL[(g * 64 + p) * 2 + 1];
        const size_t row0 = (size_t)g * S5ROWS + b * NCHUNK;
        float xr = 0.f, xi = 0.f;
        f32x2 nv[16];
#pragma unroll
        for (int k = 0; k < 16; ++k) nv[k] = *(const f32x2*)(S + (row0 + k) * 128 + 2 * p);
        for (int c0 = 0; c0 < NCHUNK; c0 += 16) { f32x2 sv[16];
#pragma unroll
            for (int k = 0; k < 16; ++k) sv[k] = nv[k];
            if (c0 + 16 < NCHUNK) {
#pragma unroll
                for (int k = 0; k < 16; ++k) nv[k] = *(const f32x2*)(S + (row0 + c0 + 16 + k) * 128 + 2 * p); }
#pragma unroll
            for (int k = 0; k < 16; ++k) { *(unsigned*)(HG + (row0 + c0 + k) * S5K + 512 + 2 * p) = cvt_pk_bf16(xr, xi);
                const float nr = ar * xr - ai * xi + sv[k].x, ni = ar * xi + ai * xr + sv[k].y; xr = nr; xi = ni; } }
    }
}

template <bool Q8> __device__ __forceinline__ void norm_router(const Frame& F, const bf16_t* x, const float* ng, const float* mod_sh, const float* mod_sc, bf16_t* H,
                                            const float* rw, const float* rb, unsigned* gcnt, int* LIST, float* GATEW, float* SAL, float* SHL, const float* SB, int dry) {
    LAS int* lcnt = (LAS int*)F.lds;
    LAS int* lbase = lcnt + 16;
    LAS int* te = lbase + 16;
    LAS int* tp = te + 512;
    LAS float* tg = (LAS float*)(tp + 512);
    LAS float* tsa = tg + 512;
    LAS float* ths = tsa + 256;
    LAS float* tlg = ths + 256;
    const int lane = F.lane, wave = F.wave, tid = F.tid;
    f32x2 rwv[4][4][4];
#pragma unroll
    for (int j = 0; j < 4; ++j)
#pragma unroll
        for (int i = 0; i < 4; ++i) { const int k = 256 * j + 4 * lane + i; const f32x4 a = *(const f32x4*)(rw + (size_t)k * 8), c = *(const f32x4*)(rw + (size_t)k * 8 + 4);
            rwv[j][i][0] = (f32x2){a.x, a.y}; rwv[j][i][1] = (f32x2){a.z, a.w}; rwv[j][i][2] = (f32x2){c.x, c.y}; rwv[j][i][3] = (f32x2){c.z, c.w}; }
    float rbv[8];
#pragma unroll
    for (int e = 0; e < 8; ++e) rbv[e] = rb[e];
    for (int blk = F.bx; blk < NTOK / 256; blk += F.G) {
        if (tid < 16) lcnt[tid] = 0;
        __syncthreads();
        const int b = blk >> 4;
        f32x4 gs[4], sh[4];
#pragma unroll
        for (int j = 0; j < 4; ++j) { const int col = 256 * j + 4 * lane; const f32x4 g4 = *(const f32x4*)(ng + col), s4 = *(const f32x4*)(mod_sc + (size_t)b * 6144 + col);
            gs[j] = g4 * (s4 + 1.0f); sh[j] = *(const f32x4*)(mod_sh + (size_t)b * 6144 + col); }
        f32x4 nx[4];
#pragma unroll
        for (int j = 0; j < 4; ++j) nx[j] = xb_ld4(x + ((size_t)blk * 256 + wave * 32) * DM + 256 * j + 4 * lane);
#pragma unroll 2
        for (int rr = 0; rr < 32; ++rr) { const int lt = wave * 32 + rr; const size_t row = (size_t)blk * 256 + lt;
            f32x4 v[4]; float ss = 0.f;
#pragma unroll
            for (int j = 0; j < 4; ++j) { v[j] = nx[j]; ss += (v[j].x * v[j].x + v[j].y * v[j].y) + (v[j].z * v[j].z + v[j].w * v[j].w); }
            if (rr + 1 < 32) {
#pragma unroll
                for (int j = 0; j < 4; ++j) nx[j] = xb_ld4(x + (row + 1) * DM + 256 * j + 4 * lane); }
            const float rstd = fast_rsq(wave_sum(ss) * (1.0f / DM) + RMS_EPS);
            u32x2* o8 = (u32x2*)(H + row * DM) + lane; float lg[8]; f32x2 lg2[4]; float amax = 0.f, hn2 = 0.f;
#pragma unroll
            for (int e = 0; e < 4; ++e) lg2[e] = (f32x2){0.f, 0.f};
#pragma unroll
            for (int j = 0; j < 4; ++j) { const f32x4 h = v[j] * rstd * gs[j] + sh[j]; v[j] = h;
                if constexpr (!Q8) { u32x2 w; w.x = cvt_pk_bf16(h.x, h.y); w.y = cvt_pk_bf16(h.z, h.w); o8[64 * j] = w; }
                else { amax = amax3(amax3(amax, h.x, h.y), h.z, h.w); hn2 += (h.x * h.x + h.y * h.y) + (h.z * h.z + h.w * h.w); }
#pragma unroll
                for (int e = 0; e < 4; ++e) lg2[e] += rwv[j][0][e] * h.x + rwv[j][1][e] * h.y + rwv[j][2][e] * h.z + rwv[j][3][e] * h.w; }
            if constexpr (Q8) {
                amax = wave_max(amax);
                const float qs = amax > 0.f ? 127.0f * fast_rcp(amax) : 0.f; unsigned* q8 = (unsigned*)((signed char*)H + row * DM) + lane;
#pragma unroll
                for (int j = 0; j < 4; ++j) __builtin_nontemporal_store(q8pack(v[j].x, v[j].y, v[j].z, v[j].w, qs), q8 + 64 * j);
                hn2 = wave_sum(hn2);
                if (lane == 0) { tsa[lt] = amax * (1.0f / 127.0f); ths[lt] = hn2; } }
#pragma unroll
            for (int e = 0; e < 8; ++e) lg[e] = wave_sum((e & 1) ? lg2[e >> 1].y : lg2[e >> 1].x) + rbv[e];
            if (lane == 0) { *(LAS f32x4*)(tlg + lt * 8) = (f32x4){lg[0], lg[1], lg[2], lg[3]}; *(LAS f32x4*)(tlg + lt * 8 + 4) = (f32x4){lg[4], lg[5], lg[6], lg[7]}; }
        }
        LDS_WAIT();
        if (lane < 32) { const int lt = wave * 32 + lane; const f32x4 la = *(const LAS f32x4*)(tlg + lt * 8), lb = *(const LAS f32x4*)(tlg + lt * 8 + 4);
            const float mylg[8] = {la.x, la.y, la.z, la.w, lb.x, lb.y, lb.z, lb.w}; float b1 = mylg[0], b2 = -3.0e38f; int i1 = 0, i2 = 0;
#pragma unroll
            for (int e = 1; e < 8; ++e) { if (mylg[e] > b1) { b2 = b1; i2 = i1; b1 = mylg[e]; i1 = e; } else if (mylg[e] > b2) { b2 = mylg[e]; i2 = e; } }
            const float g1 = 1.0f / (1.0f + __expf(b2 - b1));
            te[lt * 2] = i1; te[lt * 2 + 1] = i2; tg[lt * 2] = g1; tg[lt * 2 + 1] = 1.0f - g1;
            tp[lt * 2] = __hip_atomic_fetch_add(lcnt + i1, 1, __ATOMIC_RELAXED, __HIP_MEMORY_SCOPE_WORKGROUP);
            tp[lt * 2 + 1] = __hip_atomic_fetch_add(lcnt + 8 + i2, 1, __ATOMIC_RELAXED, __HIP_MEMORY_SCOPE_WORKGROUP);
            }
        __syncthreads();
        if (tid < 16) lbase[tid] = dry ? 0 : (int)__hip_atomic_fetch_add(gcnt + tid, (unsigned)lcnt[tid], __ATOMIC_RELAXED, __HIP_MEMORY_SCOPE_AGENT);
        __syncthreads();
        if (tid < 512 && !dry) { const int lt = tid >> 1, s = tid & 1; const int e = te[lt * 2 + s]; const int pos = lbase[s * 8 + e] + tp[lt * 2 + s];
            LIST[(size_t)(s * 8 + e) * NTOK + pos] = blk * 256 + lt; GATEW[(size_t)(s * 8 + e) * NTOK + pos] = tg[lt * 2 + s];
            if constexpr (Q8) {
                const float rg = SB[2 * e] * (127.0f / WQ), ru = SB[2 * e + 1] * (127.0f / WQ);
                const float shl = fmaxf(QH * ths[lt] * rg * ru, 1e-20f) * (1.0f / 127.0f), sg = tsa[lt] * SB[2 * e], su = tsa[lt] * SB[2 * e + 1];
                SHL[(size_t)(s * 8 + e) * NTOK + pos] = shl; WSP<f32x2>(F, WS_REC)[(size_t)(s * 8 + e) * NTOK + pos] = (f32x2){__int_as_float(blk * 256 + lt), tg[lt * 2 + s] * shl}; ((f32x2*)SAL)[(size_t)(s * 8 + e) * NTOK + pos] = (f32x2){-sg * LOG2E, sg * su / shl}; } }
        __syncthreads();
    }
}

__device__ __forceinline__ void mod_phase(const Frame& F, const float* c, const float* mod_w, const float* mod_b, float* MOD, bf16_t* GATEB) {
    LAS float* cond = (LAS float*)F.lds; LAS float* red = cond + 16384;
    const int tid = F.tid;
    for (int idx = tid; idx < 16384; idx += 512) { const int b = idx >> 10, k = idx & 1023; cond[k * 16 + b] = silu_f(c[idx]); }
    __syncthreads();
    const int kq = tid >> 5, col = tid & 31;
    for (int item = F.bx; item < 4 * 192; item += F.G) { const int l = item / 192, col0 = (item - l * 192) * 32;
        float acc[16];
#pragma unroll
        for (int b = 0; b < 16; ++b) acc[b] = 0.f;
        const float* wp = mod_w + ((size_t)l * DM) * 6144 + col0 + col;
#pragma unroll 4
        for (int kk = 0; kk < 64; ++kk) { const int k = kk * 16 + kq; const float w = wp[(size_t)k * 6144];
            const LAS f32x4* cp = (const LAS f32x4*)(cond + k * 16); const f32x4 c0 = cp[0], c1 = cp[1], c2 = cp[2], c3 = cp[3];
            acc[0] += c0.x * w; acc[1] += c0.y * w; acc[2] += c0.z * w; acc[3] += c0.w * w; acc[4] += c1.x * w; acc[5] += c1.y * w; acc[6] += c1.z * w; acc[7] += c1.w * w;
            acc[8] += c2.x * w; acc[9] += c2.y * w; acc[10] += c2.z * w; acc[11] += c2.w * w; acc[12] += c3.x * w; acc[13] += c3.y * w; acc[14] += c3.z * w; acc[15] += c3.w * w; }
#pragma unroll
        for (int b = 0; b < 16; ++b) red[(kq * 16 + b) * 32 + col] = acc[b];
        __syncthreads();
        { const int b = tid >> 5; float s = mod_b[(size_t)l * 6144 + col0 + col];
#pragma unroll
          for (int q = 0; q < 16; ++q) s += red[(q * 16 + b) * 32 + col];
          MOD[((size_t)l * 16 + b) * 6144 + col0 + col] = s;
          if (col0 >= 5 * DM) GATEB[((size_t)l * 16 + b) * 1024 + (col0 - 5 * DM) + col] = (bf16_t)(cvt_pk_bf16(s, s) & 0xffffu); }
        __syncthreads();
    }
}
__device__ __forceinline__ void rope_phase(const Frame& F, const int* positions, float* ROPE) {
    for (int idx = F.bx * 512 + F.tid; idx < NTOK * 8; idx += F.G * 512) { const int tok = idx >> 3, f = idx & 7;
        const float inv = exp2f(-(float)f * 0.125f * 18.931568569324174f);
        const float ang = (float)positions[tok] * inv; float sn, cs; sincosf(ang, &sn, &cs);
        ROPE[(size_t)tok * 16 + f] = cs; ROPE[(size_t)tok * 16 + 8 + f] = sn; }
}
__device__ __forceinline__ void conv_item_i8(const float* W, int K, int N, signed char* Wt, int row_off, LAS float* scr, int item, int lane, float qs, int mode) {
    const int nblk = N / 64, kb = item / nblk, nb = item - kb * nblk, k0 = 64 * kb, n0 = 64 * nb;
    const int kr = lane >> 4, nq = lane & 15;
    f32x4 v[16];
    const float* src = W + (size_t)(k0 + kr) * N + n0 + 4 * nq;
#pragma unroll
    for (int i = 0; i < 16; ++i) v[i] = *(const f32x4*)(src + (size_t)(4 * i) * N);
    int nqd = nq; if (mode == 1 && n0 < 1024) nqd = (nq == 1) ? 2 : ((nq == 2) ? 1 : nq);
#pragma unroll
    for (int i = 0; i < 16; ++i) { const int kk = 4 * i + kr; *(LAS f32x4*)(scr + kk * 64 + ((4 * nqd) ^ ((kk >> 3) << 3))) = v[i]; }
    LDS_WAIT(); asm volatile("" ::: "memory");
    const int c = lane & 3;
#pragma unroll
    for (int j = 0; j < 4; ++j) { const int n = (lane >> 2) + 16 * j;
        const LAS float* s0 = scr + (16 * c) * 64 + (n ^ ((2 * c) << 3)); const LAS float* s1 = scr + (16 * c + 8) * 64 + (n ^ ((2 * c + 1) << 3));
        u32x4 o; o.x = q8pack(s0[0 * 64], s0[1 * 64], s0[2 * 64], s0[3 * 64], qs); o.y = q8pack(s0[4 * 64], s0[5 * 64], s0[6 * 64], s0[7 * 64], qs);
        o.z = q8pack(s1[0 * 64], s1[1 * 64], s1[2 * 64], s1[3 * 64], qs); o.w = q8pack(s1[4 * 64], s1[5 * 64], s1[6 * 64], s1[7 * 64], qs);
        *(u32x4*)(Wt + (size_t)(row_off + n0 + n) * K + k0 + 16 * c) = o; }
    LDS_WAIT(); asm volatile("" ::: "memory");
}
__device__ __forceinline__ int conv_run_i8(const Frame& F, const float* W, signed char* Wt, int K, int N, int row_off, int base, LAS float* scr, float* sb_out, int mode = 0) {
    const int gw = F.bx * 8 + F.wave, NGW = F.G * 8, nitems = (K / 64) * (N / 64);
    float ss = 0.f;
#pragma unroll
    for (int i = 0; i < 16; ++i) { const f32x4 t = *(const f32x4*)(W + (size_t)(i * 64 + F.lane) * 4); ss += (t.x * t.x + t.y * t.y) + (t.z * t.z + t.w * t.w); }
    const float range = WQ * sqrtf(wave_sum(ss) * (1.0f / 4096.0f)) + 1e-30f, qs = 127.0f / range;
    if (gw == 0 && F.lane == 0) *sb_out = range * (1.0f / 127.0f);
    int first = (gw - base) % NGW; if (first < 0) first += NGW;
    for (int it = first; it < nitems; it += NGW) conv_item_i8(W, K, N, Wt, row_off, scr, it, F.lane, qs, mode);
    return base + nitems;
}

__device__ __forceinline__ int conv_run(const Frame& F, const float* W, bf16_t* Wt, int K, int N, int ldt, int row_off, int mode, int base, LAS float* scr) {
    const int gw = F.bx * 8 + F.wave, NGW = F.G * 8, nitems = (K / 64) * (N / 64);
    int first = (gw - base) % NGW; if (first < 0) first += NGW;
    for (int it = first; it < nitems; it += NGW) conv_item(W, K, N, Wt, ldt, row_off, scr, it, F.lane, mode);
    return base + nitems;
}

#ifndef PHASE_MASK
#define PHASE_MASK 0xffffffffu
#endif
constexpr unsigned PH = PHASE_MASK;
#define PHON(k) ((PH >> (k)) & 1u)
#ifndef DUP_MASK
#define DUP_MASK 0u
#endif
#define DUPON(k) (((DUP_MASK) >> (k)) & 1u)
#ifndef I8_ALL
#define I8_ALL 1
#endif
#ifndef DRY17
#define DRY17 0
#endif
struct Args { const void* in[29]; float* out; unsigned char* ws; int pad0, pad1; };

__device__ __forceinline__ void grid_bar(const Frame& F) {
    XcdBarrier b; b.bar = WSP<unsigned>(F, WS_CTL) + CW_BAR; b.x = xb_xcc_id(); b.st = (volatile LAS unsigned*)(F.lds - RING_OFF + MISC_OFF) + 8;
    xcd_barrier(b);
}

__global__ void __launch_bounds__(512, 2) trunk_fwd(Args args) {
    extern __shared__ __attribute__((aligned(16))) unsigned char lds_raw[];
    Frame F; F.lds = (LAS unsigned char*)lds_raw + RING_OFF; F.tid = threadIdx.x; F.lane = F.tid & 63; F.wave = __builtin_amdgcn_readfirstlane(F.tid >> 6); F.G = gridDim.x; F.bx = blockIdx.x;
    const Frame& F0 = F;
    for (int u = F.tid; u < LDSCTL_BYTES / 4; u += 512) ((LAS unsigned*)((LAS unsigned char*)lds_raw + LDSCTL_OFF))[u] = 0u;
    __syncthreads();
    if (F.tid < 31) { const void* p = (F.tid < 29) ? args.in[F.tid] : (F.tid == 29 ? (const void*)args.out : (const void*)args.ws);
        const unsigned long long v = (unsigned long long)p; LAS unsigned* t = (LAS unsigned*)((LAS unsigned char*)lds_raw + PTAB_OFF) + 2 * F.tid; t[0] = (unsigned)v; t[1] = (unsigned)(v >> 32); }
    __syncthreads();
    (void)xcd_barrier_post(WSP<unsigned>(F, WS_CTL) + CW_BAR, (volatile LAS unsigned*)((LAS unsigned char*)lds_raw + MISC_OFF) + 8);
#define GRID_BAR() grid_bar(F)
#if DUP_MASK
#define PHASE(k) if (PHON(k)) for (int rep_ = DUPON(k) ? 0 : 1; rep_ < 2; ++rep_) if (const int dry_ = opaque_i(rep_ == 0 ? 1 : 0); true) if (const Frame F = fresh(F0); true)
#else
#define PHASE(k) if (PHON(k)) if (constexpr int dry_ = 0; true) if (const Frame F = fresh(F0); true)
#endif
    LAS float* scr = (LAS float*)(F.lds + F.wave * 16384);

    PHASE(0) mod_phase(F, PT<const float>(F, P_C), PT<const float>(F, P_MODW), PT<const float>(F, P_MODB), WSP<float>(F, WS_MOD), WSP<bf16_t>(F, WS_GATEB));
    PHASE(0) rope_phase(F, PT<const int>(F, P_POS), WSP<float>(F, WS_ROPE));
    PHASE(1) {
        int base = 0;
        for (int i = 0; i < 2; ++i) {
            base = conv_run_i8(F, PT<const float>(F, P_WIN) + (size_t)i * DM * NWIN, WSP<signed char>(F, WS_WIN) + (size_t)i * NWIN * DM, DM, NWIN, 0, base, scr, WSP<float>(F, WS_SB) + SBF_OFF + 8 + i, 1);
            base = conv_run(F, PT<const float>(F, P_WOUT) + (size_t)i * DM * DM, WSP<bf16_t>(F, WS_WOUT) + (size_t)i * DM * DM, DM, DM, DM, 0, 2, base, scr);
            base = conv_run_i8(F, PT<const float>(F, P_FG) + (size_t)i * DM * DFF, WSP<signed char>(F, WS_WGU) + (size_t)i * 2 * DFF * DM, DM, DFF, 0, base, scr, WSP<float>(F, WS_SB) + SBF_OFF + 3 * i);
            base = conv_run_i8(F, PT<const float>(F, P_FU) + (size_t)i * DM * DFF, WSP<signed char>(F, WS_WGU) + (size_t)i * 2 * DFF * DM, DM, DFF, DFF, base, scr, WSP<float>(F, WS_SB) + SBF_OFF + 3 * i + 1);
            base = conv_run_i8(F, PT<const float>(F, P_FD) + (size_t)i * DFF * DM, WSP<signed char>(F, WS_WDN) + (size_t)i * DM * DFF, DFF, DM, 0, base, scr, WSP<float>(F, WS_SB) + SBF_OFF + 3 * i + 2);
            base = conv_run(F, PT<const float>(F, P_GLUW) + (size_t)i * DM * 2 * DM, WSP<bf16_t>(F, WS_WGLU) + (size_t)i * 2 * DM * DM, DM, 2 * DM, DM, 0, 0, base, scr);
        }
    }
    GRID_BAR();

    for (int li = 0; li < 2; ++li) {
        {
            const int L = 2 * li; const int modoff = L * 16 * 6144;
            PHASE(2) { const float* modL = WSP<const float>(F, WS_MOD) + modoff;
                if (li == 0) norm_plain<2, true>(F, PT<const float>(F, P_X), PT<const float>(F, P_NMIX) + L * DM, modL + 0 * DM, modL + 1 * DM, WSP<bf16_t>(F, WS_H), nullptr, WSP<float>(F, WS_SHT), nullptr);
                else norm_plain<2, false>(F, WSP<const bf16_t>(F, WS_XB), PT<const float>(F, P_NMIX) + L * DM, modL + 0 * DM, modL + 1 * DM, WSP<bf16_t>(F, WS_H), nullptr, WSP<float>(F, WS_SHT), nullptr); }
            GRID_BAR();
            PHASE(3) { SchedWin S{F.G, F.bx}; EpiWin<true> E{F, li};
              pg8::gemm_phase<EpiWin<true>, SchedWin, false, DM / 2, DM / 2, DM / 2, true>(F.lds, WSP<const bf16_t>(F, WS_H), (const bf16_t*)(WSP<const signed char>(F, WS_WIN) + (size_t)li * NWIN * DM), S, E, nullptr); }
            GRID_BAR();
            PHASE(4) { unsigned char* big = WSP<unsigned char>(F, WS_BIG);
                attn_phase(F, (const bf16_t*)(big + BG_Q), (const bf16_t*)(big + BG_K), (const bf16_t*)(big + BG_V), (bf16_t*)(big + BG_OB), (float*)(big + BG_LSE)); }
            GRID_BAR();
            PHASE(5) { unsigned char* big = WSP<unsigned char>(F, WS_BIG);
                combine_phase(F, (const bf16_t*)(big + BG_OB), (const float*)(big + BG_LSE), (const bf16_t*)(big + BG_BG), (const bf16_t*)(big + BG_U), PT<const float>(F, P_CONVW) + (size_t)li * 3 * CW, WSP<bf16_t>(F, WS_H)); }
            GRID_BAR();
            PHASE(6) { SchedPlain<NTOK / 256, DM / 256> S{F.G, F.bx}; EpiRes E{F, li == 0 ? 1 : 0, modoff + 2 * DM, dry_};
              pg8::gemm_phase<EpiRes, SchedPlain<NTOK / 256, DM / 256>, false, DM, DM, DM>(F.lds, WSP<const bf16_t>(F, WS_H), WSP<const bf16_t>(F, WS_WOUT) + (size_t)li * DM * DM, S, E, nullptr); }
            GRID_BAR();
            PHASE(2) { const float* modL = WSP<const float>(F, WS_MOD) + modoff;
                norm_plain<1, false>(F, WSP<const bf16_t>(F, WS_XB), PT<const float>(F, P_NFFN) + L * DM, modL + 3 * DM, modL + 4 * DM, WSP<bf16_t>(F, WS_H), WSP<float>(F, WS_SCT), WSP<float>(F, WS_SHT), WSP<const float>(F, WS_SB) + SBF_OFF + 3 * li); }
            GRID_BAR();
            PHASE(7) { SchedPair<NTOK / 256, DFF / 128, DFF> S{F.G, F.bx}; EpiActI8<DFF, false, true> E{F, 0, li, 0};
              pg8::gemm_phase<EpiActI8<DFF, false, true>, SchedPair<NTOK / 256, DFF / 128, DFF>, false, DM / 2, DM / 2, DM / 2, true>(F.lds, WSP<const bf16_t>(F, WS_H), (const bf16_t*)(WSP<const signed char>(F, WS_WGU) + (size_t)li * 2 * DFF * DM), S, E, nullptr); }
            GRID_BAR();
            PHASE(8) { SchedPlain<NTOK / 256, DM / 256> S{F.G, F.bx}; EpiResI8 E{F, modoff + 5 * DM, li, dry_};
              pg8::gemm_phase<EpiResI8, SchedPlain<NTOK / 256, DM / 256>, false, DFF / 2, DFF / 2, DFF / 2, true>(F.lds, WSP<const bf16_t>(F, WS_BIG + BG_HID), (const bf16_t*)(WSP<const signed char>(F, WS_WDN) + (size_t)li * DM * DFF), S, E, nullptr); }
            GRID_BAR();
        }
        {
            const int L = 2 * li + 1; const int modoff = L * 16 * 6144;
            PHASE(9) for (int it = F.bx; it < 4 * SG; it += F.G)
                s5_precompute(F, it, PT<const float>(F, P_ARE) + (size_t)li * SG * SP, PT<const float>(F, P_AIM) + (size_t)li * SG * SP, PT<const float>(F, P_LSTEP) + (size_t)li * SG,
                              PT<const float>(F, P_BRE) + (size_t)li * SG * SP * SC, PT<const float>(F, P_BIM) + (size_t)li * SG * SP * SC,
                              PT<const float>(F, P_CRE) + (size_t)li * SG * SC * SP, PT<const float>(F, P_CIM) + (size_t)li * SG * SC * SP, PT<const float>(F, P_SD) + (size_t)li * DM,
                              WSP<bf16_t>(F, WS_BIG + BG_BT2), WSP<bf16_t>(F, WS_BIG + BG_W1T), WSP<float>(F, WS_AL));
            PHASE(10) {
                int base = 0;
                for (int e = 0; e < NE; ++e) {
                    if (I8_ALL || li == 1) {
                        base = conv_run_i8(F, PT<const float>(F, P_MG) + ((size_t)li * NE + e) * DM * DFE, WSP<signed char>(F, WS_WMGU) + (size_t)e * 2 * DFE * DM, DM, DFE, 0, base, scr, WSP<float>(F, WS_SB) + 2 * e);
                        base = conv_run_i8(F, PT<const float>(F, P_MU) + ((size_t)li * NE + e) * DM * DFE, WSP<signed char>(F, WS_WMGU) + (size_t)e * 2 * DFE * DM, DM, DFE, DFE, base, scr, WSP<float>(F, WS_SB) + 2 * e + 1);
                    } else {
                    base = conv_run(F, PT<const float>(F, P_MG) + ((size_t)li * NE + e) * DM * DFE, WSP<bf16_t>(F, WS_WMGU) + (size_t)e * 2 * DFE * DM, DM, DFE, DM, 0, 0, base, scr);
                    base = conv_run(F, PT<const float>(F, P_MU) + ((size_t)li * NE + e) * DM * DFE, WSP<bf16_t>(F, WS_WMGU) + (size_t)e * 2 * DFE * DM, DM, DFE, DM, DFE, 0, base, scr); }
                    base = conv_run_i8(F, PT<const float>(F, P_MD) + ((size_t)li * NE + e) * DFE * DM, WSP<signed char>(F, WS_WMDN) + (size_t)e * DM * DFE, DFE, DM, 0, base, scr, WSP<float>(F, WS_SB) + 16 + e);
                }
            }
            PHASE(11) { const float* modL = WSP<const float>(F, WS_MOD) + modoff;
                norm_s5(F, WSP<const bf16_t>(F, WS_XB), PT<const float>(F, P_NMIX) + L * DM, modL + 0 * DM, modL + 1 * DM, WSP<bf16_t>(F, WS_BIG + BG_HG)); }
            GRID_BAR();
            PHASE(12) { SchedS5A S{F.G, F.bx}; EpiS5A E{F};
              pg8::gemm_phase<EpiS5A, SchedS5A, false, S5K, 512, 512>(F.lds, WSP<const bf16_t>(F, WS_BIG + BG_HG), WSP<const bf16_t>(F, WS_BIG + BG_W1T), S, E, nullptr); }
            GRID_BAR();
            PHASE(13) s5_scan(F, WSP<const float>(F, WS_BIG + BG_S), WSP<const float>(F, WS_AL), WSP<bf16_t>(F, WS_BIG + BG_HG));
            GRID_BAR();
            PHASE(14) { SchedS5B S{F.G, F.bx}; EpiS5B E{F};
              pg8::gemm_phase<EpiS5B, SchedS5B, false, S5K, S5K, S5K>(F.lds, WSP<const bf16_t>(F, WS_BIG + BG_HG), WSP<const bf16_t>(F, WS_BIG + BG_BT2), S, E, nullptr); }
            GRID_BAR();
            PHASE(15) { SchedPair<NTOK / 256, DM / 128, DM> S{F.G, F.bx}; EpiGlu E{F, modoff + 2 * DM, li, dry_};
              pg8::gemm_phase<EpiGlu, SchedPair<NTOK / 256, DM / 128, DM>, false, DM, DM, DM>(F.lds, WSP<const bf16_t>(F, WS_H), WSP<const bf16_t>(F, WS_WGLU) + (size_t)li * 2 * DM * DM, S, E, nullptr); }
            GRID_BAR();
            PHASE(16) { const float* modL = WSP<const float>(F, WS_MOD) + modoff;
                if (I8_ALL || li == 1) norm_router<true>(F, WSP<const bf16_t>(F, WS_XB), PT<const float>(F, P_NFFN) + L * DM, modL + 3 * DM, modL + 4 * DM, WSP<bf16_t>(F, WS_H), PT<const float>(F, P_RW) + (size_t)li * DM * NE, PT<const float>(F, P_RB) + (size_t)li * NE,
                            WSP<unsigned>(F, WS_CTL) + CW_MOECNT + li * 16, WSP<int>(F, WS_LIST), WSP<float>(F, WS_GATEW), WSP<float>(F, WS_SCL), WSP<float>(F, WS_SHL), WSP<const float>(F, WS_SB), dry_);
                else norm_router<false>(F, WSP<const bf16_t>(F, WS_XB), PT<const float>(F, P_NFFN) + L * DM, modL + 3 * DM, modL + 4 * DM, WSP<bf16_t>(F, WS_H), PT<const float>(F, P_RW) + (size_t)li * DM * NE, PT<const float>(F, P_RB) + (size_t)li * NE,
                            WSP<unsigned>(F, WS_CTL) + CW_MOECNT + li * 16, WSP<int>(F, WS_LIST), WSP<float>(F, WS_GATEW), WSP<float>(F, WS_SCL), WSP<float>(F, WS_SHL), WSP<const float>(F, WS_SB), dry_); }
            GRID_BAR();
            for (int slot = 0; slot < 2; ++slot) {
                PHASE(17) { const unsigned* gc = WSP<const unsigned>(F, WS_CTL) + CW_MOECNT + li * 16; int cc = F.bx;
                  if (slot == 1) { const int r8 = ((moe_tiles(gc) * (DM / 256)) % F.G) & ~7; cc = (F.bx + F.G - r8) % F.G; }
                  moe_table(F, gc + slot * 8); SchedMoe<DFE / 128, 0> S{F.G, cc, slot * 8 * NTOK}; EpiActI8<DFE, true, true> E{F, DRY17 ? dry_ : 0, li, slot};
                  pg8::gemm_phase<EpiActI8<DFE, true, true>, SchedMoe<DFE / 128, 0>, true, DM / 2, DM / 2, DM / 2, true>(F.lds, WSP<const bf16_t>(F, WS_H), WSP<const bf16_t>(F, WS_WMGU), S, E, WSP<const int>(F, WS_LIST)); }
                GRID_BAR();
                PHASE(18) { moe_table(F, WSP<const unsigned>(F, WS_CTL) + CW_MOECNT + li * 16 + slot * 8);
                  { SchedMoe<DM / 256, 1> S{F.G, F.bx, slot * 8 * NTOK}; EpiMoeDownI8<false> E{F, L, dry_};
                    pg8::gemm_phase<EpiMoeDownI8<false>, SchedMoe<DM / 256, 1>, false, DFE / 2, DFE / 2, DFE / 2, true>(F.lds, (const bf16_t*)(WSP<const signed char>(F, WS_BIG + BG_HID) + (size_t)slot * HID_SLOT), WSP<const bf16_t>(F, WS_WMDN), S, E, nullptr); }
                  { SchedMoe<DM / 256, 2> S{F.G, F.bx, slot * 8 * NTOK}; EpiMoeDownI8<true> E{F, L, dry_};
                    pg8::gemm_phase<EpiMoeDownI8<true>, SchedMoe<DM / 256, 2>, false, DFE / 2, DFE / 2, DFE / 2, true>(F.lds, (const bf16_t*)(WSP<const signed char>(F, WS_BIG + BG_HID) + (size_t)slot * HID_SLOT), WSP<const bf16_t>(F, WS_WMDN), S, E, nullptr); } }
                if (slot == 1) GRID_BAR();
            }
        }
    }
    PHASE(19) norm_final(F, WSP<const bf16_t>(F, WS_XB), PT<float>(F, P_OUT), PT<const float>(F, P_FNG));
}

extern "C" void kernel_launch(void* const* d_in, const int* in_sizes, int n_in, void* d_out, int out_size, void* d_ws, size_t ws_size, hipStream_t stream) {
    static int grid = 0;
    if (grid == 0) {
        if (n_in != 29 || in_sizes[0] != NTOK * DM || out_size != NTOK * DM || ws_size < WS_END) { fprintf(stderr, "kernel_launch: unexpected shapes (n_in %d, in0 %d, out %d, ws %zu < %zu)\n", n_in, n_in > 0 ? in_sizes[0] : -1, out_size, ws_size, (size_t)WS_END); grid = -1; return; }
        int dev = 0, cus = 0, per_cu = 0;
        if (hipGetDevice(&dev) != hipSuccess || hipDeviceGetAttribute(&cus, hipDeviceAttributeMultiprocessorCount, dev) != hipSuccess) { grid = -1; return; }
        if (hipFuncSetAttribute((const void*)trunk_fwd, hipFuncAttributeMaxDynamicSharedMemorySize, LDS_BYTES) != hipSuccess) { fprintf(stderr, "kernel_launch: hipFuncSetAttribute failed\n"); grid = -1; return; }
        if (hipOccupancyMaxActiveBlocksPerMultiprocessor(&per_cu, (const void*)trunk_fwd, 512, LDS_BYTES) != hipSuccess || per_cu < 1) fprintf(stderr, "kernel_launch: occupancy query says %d\n", per_cu);
        (void)hipGetLastError();
        grid = cus;
    }
    if (grid < 0) return;
    if (hipMemsetAsync((char*)d_ws + WS_CTL, 0, CTL_ZERO_BYTES, stream) != hipSuccess) return;
    Args a{};
    for (int i = 0; i < 29; ++i) a.in[i] = d_in[i];
    a.out = (float*)d_out; a.ws = (unsigned char*)d_ws; a.pad0 = 0; a.pad1 = 0;
    hipLaunchKernelGGL(trunk_fwd, dim3(grid), dim3(512), LDS_BYTES, stream, a);
}
```

```cpp
#include <hip/hip_runtime.h>
#include <cstdio>
#include <cstdint>
#include <type_traits>

#define LAS __attribute__((address_space(3)))
#define GAS __attribute__((address_space(1)))
typedef unsigned short bf16_t;
typedef short bf16x8 __attribute__((ext_vector_type(8)));
typedef float f32x4 __attribute__((ext_vector_type(4)));
typedef float f32x2 __attribute__((ext_vector_type(2)));
typedef float f32x16 __attribute__((ext_vector_type(16)));
typedef unsigned u32x4 __attribute__((ext_vector_type(4)));
typedef unsigned u32x2 __attribute__((ext_vector_type(2)));
typedef int i32x4 __attribute__((ext_vector_type(4)));

constexpr int DM = 1024, NB = 16, SEQ = 4096, NTOK = NB * SEQ;
constexpr int NH = 8, HD = 64, AW = 512, CW = 512;
constexpr int DFF = 2816, NE = 8, DFE = 3584;
constexpr int NWIN = 3072;
constexpr int SG = 64, SP = 64, SC = 16, SL = 32;
constexpr int NCHUNK = SEQ / SL;
constexpr int S5ROWS = NB * NCHUNK;
constexpr int S5K = SL * SC + 2 * SP;
constexpr float RMS_EPS = 1e-6f;
constexpr float LOG2E = 1.4426950408889634f;
constexpr float QSCALE = 0.125f * LOG2E;

constexpr size_t MiB = 1u << 20;
constexpr size_t WS_CTL = 0, CTL_ZERO_BYTES = 1 * MiB;
constexpr size_t WS_MOD = 1 * MiB;
constexpr size_t WS_GATEB = WS_MOD + 1536 * 1024;
constexpr size_t WS_ROPE = 3 * MiB;
constexpr size_t WS_LIST = 7 * MiB;
constexpr size_t WS_GATEW = 11 * MiB;
constexpr size_t WS_AL = 15 * MiB;
constexpr size_t WS_SB = WS_AL + 65536;
constexpr size_t WS_SHT = WS_AL + 131072, WS_SCT = WS_AL + 393216;
constexpr int SBF_OFF = 64;
constexpr float QH = 8.0f, WQ = 4.0f;
constexpr size_t WS_SCL = 16 * MiB;
constexpr size_t WS_SHL = 24 * MiB;
constexpr size_t WS_SAT = WS_SHT, WS_SAL = WS_SHL;
constexpr size_t WS_WIN = 28 * MiB;
constexpr size_t WS_WOUT = 40 * MiB;
constexpr size_t WS_WGU = 44 * MiB;
constexpr size_t WS_WDN = 66 * MiB;
constexpr size_t WS_WGLU = 77 * MiB;
constexpr size_t WS_WMGU = 85 * MiB;
constexpr size_t WS_REC = 160 * MiB;
constexpr size_t WS_WMDN = 197 * MiB;
constexpr size_t WS_H = 253 * MiB;
constexpr size_t WS_BIG = 381 * MiB;
constexpr size_t WS_XB = WS_BIG + 520 * MiB;
constexpr size_t WS_END = WS_XB + 128 * MiB;
constexpr size_t BG_Q = 0, BG_K = 64 * MiB, BG_V = 128 * MiB, BG_BG = 192 * MiB, BG_U = 256 * MiB, BG_OB = 320 * MiB  , BG_LSE = 512 * MiB  ;
constexpr size_t HID_SLOT = 232 * MiB;
constexpr size_t BG_HID = 0;
constexpr size_t BG_HG = 0;
constexpr size_t BG_S = 160 * MiB;
constexpr size_t BG_BT2 = 224 * MiB;
constexpr size_t BG_W1T = 264 * MiB;
constexpr int CW_TMO = 0;
constexpr int CW_MOECNT = 64;
constexpr int CW_BAR = 4096;

constexpr int LDSCTL_OFF = 0, LDSCTL_BYTES = 8192, MISC_OFF = LDSCTL_OFF + 320;
constexpr int ROWBUF_OFF = 2048;
constexpr int UTAB_OFF = 6144, UTAB_N = 64;
constexpr int RING_OFF = 8192, RING_BYTES = 131072;
constexpr int LDS_BYTES = 147456;

#define LDS_WAIT() asm volatile("s_waitcnt lgkmcnt(0)" ::: "memory")
#define VM_WAIT() asm volatile("s_waitcnt vmcnt(0)" ::: "memory")
#define RLX_AGENT __ATOMIC_RELAXED, __HIP_MEMORY_SCOPE_AGENT

__device__ __forceinline__ unsigned cvt_pk_bf16(float lo, float hi) { unsigned r; asm volatile("v_cvt_pk_bf16_f32 %0, %1, %2" : "=v"(r) : "v"(lo), "v"(hi)); return r; }
__device__ __forceinline__ float bf_lo(unsigned w) { return __uint_as_float(w << 16); }
__device__ __forceinline__ float bf_hi(unsigned w) { return __uint_as_float(w & 0xffff0000u); }
template <int CTRL> __device__ __forceinline__ float dppf(float v) { return __builtin_bit_cast(float, __builtin_amdgcn_update_dpp(0, __builtin_bit_cast(int, v), CTRL, 0xf, 0xf, false)); }
__device__ __forceinline__ float wave_sum(float v) {
    v += dppf<0xB1>(v); v += dppf<0x4E>(v); v += dppf<0x124>(v); v += dppf<0x128>(v);
    { auto r = __builtin_amdgcn_permlane16_swap(__float_as_uint(v), __float_as_uint(v), false, false); v = __uint_as_float(r[0]) + __uint_as_float(r[1]); }
    { auto r = __builtin_amdgcn_permlane32_swap(__float_as_uint(v), __float_as_uint(v), false, false); v = __uint_as_float(r[0]) + __uint_as_float(r[1]); }
    return v;
}
__device__ __forceinline__ float swap32add(float a, float b) { auto r = __builtin_amdgcn_permlane32_swap(__float_as_uint(a), __float_as_uint(b), false, false); return __uint_as_float(r[0]) + __uint_as_float(r[1]); }
__device__ __forceinline__ float swap16add(float a, float b) { auto r = __builtin_amdgcn_permlane16_swap(__float_as_uint(a), __float_as_uint(b), false, false); return __uint_as_float(r[0]) + __uint_as_float(r[1]); }
__device__ __forceinline__ float row_sum(float v) { v += dppf<0xB1>(v); v += dppf<0x4E>(v); v += dppf<0x124>(v); v += dppf<0x128>(v); return v; }
__device__ __forceinline__ float wave_max(float v) {
    v = fmaxf(v, dppf<0xB1>(v)); v = fmaxf(v, dppf<0x4E>(v)); v = fmaxf(v, dppf<0x124>(v)); v = fmaxf(v, dppf<0x128>(v));
    { auto r = __builtin_amdgcn_permlane16_swap(__float_as_uint(v), __float_as_uint(v), false, false); v = fmaxf(__uint_as_float(r[0]), __uint_as_float(r[1])); }
    { auto r = __builtin_amdgcn_permlane32_swap(__float_as_uint(v), __float_as_uint(v), false, false); v = fmaxf(__uint_as_float(r[0]), __uint_as_float(r[1])); }
    return v;
}
constexpr float Q8N = 256.0f / 32767.0f, Q8H = 128.0f / 32767.0f;
__device__ __forceinline__ unsigned q8hi(float n0, float n1, float n2, float n3) {
    const unsigned a = __builtin_bit_cast(unsigned, __builtin_amdgcn_cvt_pknorm_i16(n0, n1)), b = __builtin_bit_cast(unsigned, __builtin_amdgcn_cvt_pknorm_i16(n2, n3));
    return __builtin_amdgcn_perm(b, a, 0x07050301u);
}
__device__ __forceinline__ unsigned q8pack(float a, float b, float c, float d, float qs) {
    const float qn = qs * Q8N;
    return q8hi(__builtin_fmaf(a, qn, Q8H), __builtin_fmaf(b, qn, Q8H), __builtin_fmaf(c, qn, Q8H), __builtin_fmaf(d, qn, Q8H));
}
__device__ __forceinline__ f32x4 xb_ld4(const bf16_t* p) { const u32x2 w = *(const u32x2*)p; return (f32x4){bf_lo(w.x), bf_hi(w.x), bf_lo(w.y), bf_hi(w.y)}; }
__device__ __forceinline__ void xb_st4(bf16_t* p, const f32x4 v) { u32x2 w; w.x = cvt_pk_bf16(v.x, v.y); w.y = cvt_pk_bf16(v.z, v.w); *(u32x2*)p = w; }
__device__ __forceinline__ float fast_exp2(float x) { return __builtin_amdgcn_exp2f(x); }
__device__ __forceinline__ float fast_rcp(float x) { return __builtin_amdgcn_rcpf(x); }
__device__ __forceinline__ float fast_rsq(float x) { return __builtin_amdgcn_rsqf(x); }
__device__ __forceinline__ float amax3(float m, float a, float b) { float r; asm("v_max3_f32 %0, %1, |%2|, |%3|" : "=v"(r) : "v"(m), "v"(a), "v"(b)); return r; }
__device__ __forceinline__ float sigmoid_f(float x) { return fast_rcp(1.0f + fast_exp2(-x * LOG2E)); }
__device__ __forceinline__ float silu_f(float x) { return x * sigmoid_f(x); }
__device__ __forceinline__ float gelu_tanh_f(float x) {
    const float u = 0.7978845608028654f * (x + 0.044715f * x * x * x);
    return x * sigmoid_f(2.0f * u);
}

__device__ __forceinline__ f32x2 gelu_tanh_2(f32x2 x) {
    constexpr float A = -2.0f * 0.7978845608028654f * LOG2E, B = A * 0.044715f;
    const f32x2 t = x * ((x * x) * (f32x2){B, B} + (f32x2){A, A});
    const f32x2 d = (f32x2){fast_exp2(t.x), fast_exp2(t.y)} + (f32x2){1.0f, 1.0f};
    return x * (f32x2){fast_rcp(d.x), fast_rcp(d.y)};
}

constexpr int PTAB_OFF = LDSCTL_OFF + 512;
enum { P_X = 0, P_C, P_POS, P_MODW, P_MODB, P_NMIX, P_NFFN, P_WIN, P_CONVW, P_WOUT, P_FG, P_FU, P_FD, P_ARE, P_AIM, P_LSTEP, P_BRE, P_BIM, P_CRE, P_CIM, P_SD, P_GLUW, P_GLUB,
       P_RW, P_RB, P_MG, P_MU, P_MD, P_FNG, P_OUT, P_WS };
struct Frame { LAS unsigned char* lds; int tid, lane, wave, G, bx; };
__device__ __forceinline__ Frame fresh(const Frame& F0) { Frame F; F.lds = F0.lds; int t = threadIdx.x; asm volatile("" : "+v"(t)); F.tid = t; F.lane = t & 63; F.wave = __builtin_amdgcn_readfirstlane(t >> 6);
    int g = gridDim.x, b = blockIdx.x; asm volatile("" : "+s"(g), "+s"(b)); F.G = g; F.bx = b; return F; }
__device__ __forceinline__ int opaque_i(int v) { asm volatile("" : "+s"(v)); return v; }
template <class T> __device__ __forceinline__ T* PT(const Frame& F, int i) {
    unsigned z = 0; asm volatile("" : "+v"(z));
    volatile LAS unsigned* t = (volatile LAS unsigned*)(LAS unsigned char*)(uintptr_t)(z + PTAB_OFF) + 2 * i;
    const unsigned lo = __builtin_amdgcn_readfirstlane(t[0]), hi = __builtin_amdgcn_readfirstlane(t[1]);
    return (T*)(GAS T*)(((unsigned long long)hi << 32) | lo);
}
template <class T> __device__ __forceinline__ T* WSP(const Frame& F, size_t off) { return (T*)(GAS T*)(GAS unsigned char*)(PT<unsigned char>(F, P_WS) + off); }

#define XB_TMO      128
#define XB_XCNT(j)  (256  + 64 * (j))
#define XB_XSUB(j)  (1280 + 64 * (j))
#define XB_XGEN(j)  (2304 + 64 * (j))
#define XB_TOP      3328
#define XB_TOPGEN   3392
#define XCD_BAR_WORDS 3456
#define XB_SPIN_CAP (1u << 22)

__device__ __forceinline__ unsigned xb_ld(unsigned* p)              { return __hip_atomic_load(p, __ATOMIC_RELAXED, __HIP_MEMORY_SCOPE_AGENT); }
__device__ __forceinline__ unsigned xb_add(unsigned* p, unsigned v) { return __hip_atomic_fetch_add(p, v, __ATOMIC_RELAXED, __HIP_MEMORY_SCOPE_AGENT); }
__device__ __forceinline__ unsigned xb_xcc_id() { return (unsigned)__builtin_amdgcn_s_getreg((3 << 11) | 20) & 0xFu; }
#define XB_SPIN(cond, bar) do { unsigned _sp = 0; while (cond) { __builtin_amdgcn_s_sleep(1); \
    if ((++_sp & 255u) == 0u) { if (xb_ld(&(bar)[XB_TMO])) break; if (_sp > XB_SPIN_CAP) { atomicAdd(&(bar)[XB_TMO], 1u); break; } } } } while (0)

struct XcdBarrier { unsigned* bar; unsigned x; volatile LAS unsigned* st; };

__device__ __forceinline__ XcdBarrier xcd_barrier_post(unsigned* bar, volatile LAS unsigned* st) {
    XcdBarrier b; b.bar = bar; b.x = xb_xcc_id(); b.st = st;
    if (threadIdx.x == 0) (void)xb_add(&bar[XB_XCNT(b.x)], 1u);
    return b;
}
__device__ __forceinline__ void xcd_barrier_complete(unsigned* bar, unsigned x, unsigned& nloc, unsigned& nx) {
    const unsigned G = gridDim.x * gridDim.y * gridDim.z;
    unsigned sum, cnt, mine, sp = 0u;
    for (;;) {
        sum = 0u; cnt = 0u; mine = 0u;
#pragma unroll
        for (unsigned j = 0; j < 16; ++j) { const unsigned c = xb_ld(&bar[XB_XCNT(j)]); sum += c; cnt += (c > 0u) ? 1u : 0u; mine = (j == x) ? c : mine; }
        if (sum == G) break;
        __builtin_amdgcn_s_sleep(1);
        if ((++sp & 255u) == 0u) { if (xb_ld(&bar[XB_TMO])) break; if (sp > XB_SPIN_CAP) { atomicAdd(&bar[XB_TMO], 1u); break; } }
    }
    nloc = mine > 0u ? mine : 1u; nx = cnt > 0u ? cnt : 1u;
}
__device__ __forceinline__ void xcd_barrier(const XcdBarrier& b) {
    asm volatile("s_waitcnt vmcnt(0)" ::: "memory");
    __syncthreads();
    if (threadIdx.x == 0) {
        unsigned* bar = b.bar;
        __builtin_amdgcn_s_waitcnt(0);
        unsigned nloc = b.st[0], nx = b.st[1];
        if (nloc == 0u) { xcd_barrier_complete(bar, b.x, nloc, nx); b.st[0] = nloc; b.st[1] = nx; }
        const unsigned old = xb_add(&bar[XB_XSUB(b.x)], 1u);
        const unsigned gen = old / nloc;
        if (old + 1u == (gen + 1u) * nloc) {
            __builtin_amdgcn_fence(__ATOMIC_RELEASE, "agent");
            asm volatile("s_waitcnt vmcnt(0)" ::: "memory");
            const unsigned og = xb_add(&bar[XB_TOP], 1u);
            const unsigned tg = og / nx;
            if (og + 1u == (tg + 1u) * nx) xb_add(&bar[XB_TOPGEN], 1u);
            else XB_SPIN(xb_ld(&bar[XB_TOPGEN]) == tg, bar);
            __builtin_amdgcn_fence(__ATOMIC_ACQUIRE, "agent");
            xb_add(&bar[XB_XGEN(b.x)], 1u);
            asm volatile("s_waitcnt vmcnt(0)" ::: "memory");
        } else {
            XB_SPIN(xb_ld(&bar[XB_XGEN(b.x)]) == gen, bar);
            __builtin_amdgcn_fence(__ATOMIC_ACQUIRE, "agent");
            asm volatile("s_waitcnt vmcnt(0)" ::: "memory");
        }
    }
    __syncthreads();
}

namespace pg8 {
constexpr int BM = 256, BK = 64, HALF = 128, HTB = HALF * BK * 2, STAGE_BYTES = 8 * HTB, NXCD = 8, WGM = 8;
__host__ __device__ __forceinline__ int lds_byte(int r, int c) { const int st = (r >> 4) * 2 + (c >> 5), rr = r & 15, cc = c & 31, ob = rr * 64 + cc * 2; return st * 1024 + (ob ^ (((ob >> 9) & 1) << 5)); }
__host__ __device__ __forceinline__ void stage_rc(int b, int& R, int& C) { const int st = b / 1024, sb = b % 1024, swz = sb ^ (((sb >> 9) & 1) << 5); R = (st >> 1) * 16 + swz / 64; C = (st & 1) * 32 + (swz % 64) / 2; }
__host__ __device__ __forceinline__ int perm32(int rho) { const int n = rho >> 4, i = rho & 15; return 8 * (i >> 2) + 4 * n + (i & 3); }

struct Unit { int arow, brow0, brow1, orow, pn, aux, nvalid, eid, par; };

__device__ __forceinline__ void tile_order_L(int Lin, int nM, int nN, int& pm, int& pn) {
    asm volatile("" : "+s"(nM), "+s"(nN));
    const int nwg = nM * nN; int wgid = Lin; { const int q = nwg / NXCD, r = nwg % NXCD, xcd = wgid % NXCD, off = wgid / NXCD; wgid = (xcd < r ? xcd * (q + 1) : r * (q + 1) + (xcd - r) * q) + off; }
    const int nig = WGM * nN, gid = wgid / nig, fm = gid * WGM, gsz = (nM - fm) < WGM ? (nM - fm) : WGM;
    pm = fm + ((wgid % nig) % gsz); pn = (wgid % nig) / gsz;
}
__device__ __forceinline__ bool tile_order(int i, int c, int G, int nM, int nN, int& pm, int& pn) {
    asm volatile("" : "+s"(nM), "+s"(nN));
    const int nwg = nM * nN; const long L = (long)i * G + c; if (L >= nwg) return false;
    int wgid = (int)L; { const int q = nwg / NXCD, r = nwg % NXCD, xcd = wgid % NXCD, off = wgid / NXCD; wgid = (xcd < r ? xcd * (q + 1) : r * (q + 1) + (xcd - r) * q) + off; }
    const int nig = WGM * nN, gid = wgid / nig, fm = gid * WGM, gsz = (nM - fm) < WGM ? (nM - fm) : WGM;
    pm = fm + ((wgid % nig) % gsz); pn = (wgid % nig) / gsz; return true;
}

template <class Sched> __device__ __forceinline__ bool utab_next(const Sched& S, int i, Unit& u) {
    if (i >= UTAB_N) return false;
    unsigned z = 0; asm volatile("" : "+v"(z));
    volatile LAS u32x4* e = (volatile LAS u32x4*)(LAS unsigned char*)(uintptr_t)(z + UTAB_OFF + i * 32);
    const u32x4 q0 = e[0], q1 = e[1];
    const int a = __builtin_amdgcn_readfirstlane((int)q0.x); if (a < 0) return false;
    u.arow = a; u.brow0 = __builtin_amdgcn_readfirstlane((int)q0.y); u.brow1 = __builtin_amdgcn_readfirstlane((int)q0.z); u.orow = __builtin_amdgcn_readfirstlane((int)q0.w); u.pn = __builtin_amdgcn_readfirstlane((int)q1.x);
    u.aux = __builtin_amdgcn_readfirstlane((int)q1.y); u.nvalid = __builtin_amdgcn_readfirstlane((int)q1.z); u.eid = __builtin_amdgcn_readfirstlane((int)q1.w); u.par = 0; return true;
}
template <class T> __device__ __forceinline__ void zero16(T& t0, T& t1, T& t2, T& t3, bf16x8 z) {
    f32x16 r; asm volatile("v_mfma_f32_32x32x16_bf16 %0, %1, %1, 0" : "=v"(r) : "v"(z));
    t0 = __builtin_bit_cast(T, (f32x4){r[0], r[1], r[2], r[3]}); t1 = __builtin_bit_cast(T, (f32x4){r[4], r[5], r[6], r[7]});
    t2 = __builtin_bit_cast(T, (f32x4){r[8], r[9], r[10], r[11]}); t3 = __builtin_bit_cast(T, (f32x4){r[12], r[13], r[14], r[15]});
}
__device__ __forceinline__ bf16x8 zero_frag() { u32x4 z; asm volatile("v_mov_b32 %0, 0\n\tv_mov_b32 %1, 0\n\tv_mov_b32 %2, 0\n\tv_mov_b32 %3, 0" : "=v"(z.x), "=v"(z.y), "=v"(z.z), "=v"(z.w)); return __builtin_bit_cast(bf16x8, z); }
template <bool I8> __device__ __forceinline__ f32x4 mma1(bf16x8 b, bf16x8 a, f32x4 c) { return __builtin_amdgcn_mfma_f32_16x16x32_bf16(b, a, c, 0, 0, 0); }
template <bool I8> __device__ __forceinline__ i32x4 mma1(bf16x8 b, bf16x8 a, i32x4 c) { return __builtin_amdgcn_mfma_i32_16x16x64_i8(__builtin_bit_cast(i32x4, b), __builtin_bit_cast(i32x4, a), c, 0, 0, 0); }
template <class Epi, class Sched, bool GATHER, int LDA, int LDB, int KDIM, bool I8 = false>
__device__ __forceinline__ void gemm_phase(LAS unsigned char* lds, const bf16_t* Ag, const bf16_t* Btg, const Sched& S, const Epi& E, const int* gather) {
    int tid = threadIdx.x; asm volatile("" : "+v"(tid));
    const int wid = __builtin_amdgcn_readfirstlane(tid >> 6), lane = tid & 63, wr = wid >> 2, wc = wid & 3, fr = lane & 15, fq = lane >> 4;
    constexpr int nt = KDIM / BK;
#ifndef PREF_BACK
#define PREF_BACK 6
#endif
    constexpr int PREF_T = (nt - PREF_BACK) > 0 ? (nt - PREF_BACK) : 0;
    static_assert(KDIM % 128 == 0 && nt >= 8, "K");
    unsigned voffA[2], voffB[2], cofs[2]; int Rr[2];
#pragma unroll
    for (int i = 0; i < 2; ++i) { int R, C; stage_rc(tid * 16 + i * 8192, R, C); const int Rb = Epi::PERM ? ((R & ~31) + perm32(R & 31)) : R;
        Rr[i] = R; cofs[i] = (unsigned)C * 2u; voffA[i] = (unsigned)(R * LDA + C) * 2u; voffB[i] = (unsigned)(Rb * LDB + C) * 2u; }
    constexpr size_t kstep = (size_t)(BK * 2);
    constexpr size_t hstepA = (size_t)HALF * LDA * 2;
    constexpr size_t rowA = (size_t)LDA * 2, rowB = (size_t)LDB * 2;
    const unsigned ldsw = (unsigned)wid * 1024u;
    const int aoff = lds_byte(wr * 64 + fr, fq * 8), boff = lds_byte(wc * 32 + fr, fq * 8);
#define PG8_SA(b, h) (((b) * 2 + (h)) * HTB)
#define PG8_SB(b, h) ((4 + (b) * 2 + (h)) * HTB)
#define PG8_STAGE(bufoff, gbase, voff) do { _Pragma("unroll") for (int _i = 0; _i < 2; ++_i) \
        __builtin_amdgcn_global_load_lds((const unsigned*)((const char*)(gbase) + (voff)[_i]), (LAS unsigned*)(lds + (bufoff) + ldsw + _i * 8192), 16, 0, 0); } while (0)
#define PG8_LDA(dst, b, h) do { _Pragma("unroll") for (int m = 0; m < 4; ++m) _Pragma("unroll") for (int k = 0; k < 2; ++k) dst[m][k] = *(const LAS bf16x8*)(lds + PG8_SA(b, h) + aoff + m * 2048 + k * 1024); } while (0)
#define PG8_LDB(dst, b, h) do { _Pragma("unroll") for (int n = 0; n < 2; ++n) _Pragma("unroll") for (int k = 0; k < 2; ++k) dst[n][k] = *(const LAS bf16x8*)(lds + PG8_SB(b, h) + boff + n * 2048 + k * 1024); } while (0)
#define PG8_MMA(ai, bj, At, Bt) do { __builtin_amdgcn_s_setprio(1); _Pragma("unroll") for (int m = 0; m < 4; ++m) _Pragma("unroll") for (int n = 0; n < 2; ++n) _Pragma("unroll") for (int k = 0; k < 2; ++k) \
        acc[ai][bj][m][n] = mma1<I8>(Bt[n][k], At[m][k], acc[ai][bj][m][n]); __builtin_amdgcn_s_setprio(0); } while (0)
#define PG8_WAIT_V(n) asm volatile("s_waitcnt vmcnt(" #n ")" ::: "memory")
#define PG8_WAIT_L(n) asm volatile("s_waitcnt lgkmcnt(" #n ")" ::: "memory")
#define PG8_BAR __builtin_amdgcn_s_barrier()
#define PG8_SCHED __builtin_amdgcn_sched_barrier(0)
#define PG8_STG_A(buf, h, isnext, koff) do { if constexpr (GATHER) { unsigned _v[2] = { (unsigned)((isnext) ? vN[h][0] : vA[h][0]) * (unsigned)rowA + cofs[0], (unsigned)((isnext) ? vN[h][1] : vA[h][1]) * (unsigned)rowA + cofs[1] }; PG8_STAGE(PG8_SA(buf, h), (const char*)Ag + (koff), _v); } \
        else { PG8_STAGE(PG8_SA(buf, h), ((isnext) ? nA : cA) + (size_t)(h) * hstepA + (koff), voffA); } } while (0)
#define PG8_STG_B(buf, h, isnext, koff) PG8_STAGE(PG8_SB(buf, h), ((isnext) ? ((h) ? nB1 : nB0) : ((h) ? cB1 : cB0)) + (koff), voffB)
#define PG8_GLOAD(dst, u) do { _Pragma("unroll") for (int _h = 0; _h < 2; ++_h) _Pragma("unroll") for (int _i = 0; _i < 2; ++_i) \
        { int _r = _h * HALF + Rr[_i]; _r = _r < (u).nvalid ? _r : (u).nvalid - 1; dst[_h][_i] = gather[(u).arow + _r]; } } while (0)
#define PG8_GUSE(v) asm volatile("" :: "v"(v[0][0]), "v"(v[0][1]), "v"(v[1][0]), "v"(v[1][1]))
#define PG8_GLOAD_ASM(dst, u) do { _Pragma("unroll") for (int _h = 0; _h < 2; ++_h) _Pragma("unroll") for (int _i = 0; _i < 2; ++_i) \
        { int _r = _h * HALF + Rr[_i]; _r = _r < (u).nvalid ? _r : (u).nvalid - 1; const int* _p = gather + ((u).arow + _r); asm volatile("global_load_dword %0, %1, off" : "=v"(dst[_h][_i]) : "v"(_p) : "memory"); } } while (0)
#define PG8_ROWPF(src_, par_) do { if constexpr (Epi::ROWPF) { if (wid < 2) { const char* _rs = (const char*)(src_) + wid * 1024 + lane * 16; \
        __builtin_amdgcn_global_load_lds((const unsigned*)_rs, (LAS unsigned*)(lds - RING_OFF + ROWBUF_OFF + ((par_) & 1) * 2048 + wid * 1024), 16, 0, 0); } } } while (0)
    { LAS int* ut = (LAS int*)(lds - RING_OFF + UTAB_OFF);
      if (tid < UTAB_N) { Unit tu; const bool ok = S.next(tid, tu); LAS int* e = ut + tid * 8;
          e[0] = ok ? tu.arow : -1; e[1] = tu.brow0; e[2] = tu.brow1; e[3] = tu.orow; e[4] = tu.pn; e[5] = tu.aux; e[6] = tu.nvalid; e[7] = tu.eid; }
      __syncthreads(); }
#define PG8_NEXT(i_, u_) pg8::utab_next(S, (i_), (u_))
    int ui = 0; bool has_next = false;
    const char *cA, *cB0, *cB1, *nA, *nB0, *nB1;
    int vA[2][2] = {{0, 0}, {0, 0}}, vN[2][2] = {{0, 0}, {0, 0}};
    const char* rsN = nullptr;
    Unit uC, uN;
    { Unit cur; if (!PG8_NEXT(0, cur)) return;
      cA = (const char*)Ag + (size_t)cur.arow * rowA; cB0 = (const char*)Btg + (size_t)cur.brow0 * rowB; cB1 = (const char*)Btg + (size_t)cur.brow1 * rowB;
      nA = cA; nB0 = cB0; nB1 = cB1;
      Unit n1; has_next = PG8_NEXT(1, n1);
      if (has_next) { nA = (const char*)Ag + (size_t)n1.arow * rowA; nB0 = (const char*)Btg + (size_t)n1.brow0 * rowB; nB1 = (const char*)Btg + (size_t)n1.brow1 * rowB; }
      if constexpr (GATHER) { PG8_GLOAD(vA, cur); if (has_next) { PG8_GLOAD(vN, n1); } else { PG8_GLOAD(vN, cur); } PG8_GUSE(vA); PG8_GUSE(vN); }
      if constexpr (Epi::ROWPF) { PG8_ROWPF(E.row_src(cur), 0); rsN = (const char*)E.row_src(has_next ? n1 : cur); }
      uC = cur; uN = has_next ? n1 : cur; }
    typedef typename std::conditional<I8, i32x4, f32x4>::type acc_t;
    acc_t acc[2][2][4][2];
    { const bf16x8 zf = zero_frag();
#pragma unroll
    for (int a = 0; a < 2; ++a)
#pragma unroll
        for (int b = 0; b < 2; ++b)
#pragma unroll
            for (int m = 0; m < 4; m += 2) zero16(acc[a][b][m][0], acc[a][b][m][1], acc[a][b][m + 1][0], acc[a][b][m + 1][1], zf); }
    bf16x8 At[4][2], B0[2][2], B1[2][2];
    PG8_STG_B(0, 0, false, 0); PG8_STG_B(0, 1, false, 0); PG8_STG_A(0, 0, false, 0); PG8_STG_A(0, 1, false, 0);
    PG8_STG_B(1, 0, false, kstep); PG8_STG_A(1, 0, false, kstep); PG8_STG_B(1, 1, false, kstep);
    if (wr == 1) PG8_BAR;
    PG8_WAIT_V(6); PG8_BAR;
    PG8_BAR;
    for (;;) {
        for (int t = 0; t < nt; t += 2) {
            const bool last = (t == nt - 2);
            const size_t k1 = (size_t)(t + 1) * kstep, k2 = last ? 0 : (size_t)(t + 2) * kstep, k3 = k2 + kstep;
            PG8_LDB(B0, 0, 0); PG8_LDB(B1, 0, 1); PG8_SCHED; PG8_LDA(At, 0, 0); PG8_STG_A(1, 1, false, k1);
            PG8_WAIT_V(8); PG8_WAIT_L(0); PG8_BAR; PG8_MMA(0, 0, At, B0); PG8_MMA(0, 1, At, B1); PG8_BAR; PG8_SCHED;
            PG8_LDA(At, 0, 1); PG8_STG_B(0, 0, last, k2); PG8_STG_B(0, 1, last, k2); PG8_STG_A(0, 0, last, k2);
            PG8_WAIT_V(8); PG8_WAIT_L(0); PG8_BAR; PG8_MMA(1, 0, At, B0); PG8_MMA(1, 1, At, B1); PG8_BAR; PG8_SCHED;
            PG8_LDB(B0, 1, 0); PG8_LDB(B1, 1, 1); PG8_SCHED; PG8_LDA(At, 1, 0); PG8_STG_A(0, 1, last, k2);
            PG8_WAIT_V(8); PG8_WAIT_L(0); PG8_BAR; PG8_MMA(0, 0, At, B0); PG8_MMA(0, 1, At, B1); PG8_BAR; PG8_SCHED;
            PG8_LDA(At, 1, 1); PG8_STG_B(1, 0, last, k3); PG8_STG_B(1, 1, last, k3); PG8_STG_A(1, 0, last, k3);
            PG8_WAIT_V(8); PG8_WAIT_L(0); PG8_BAR; PG8_MMA(1, 0, At, B0); PG8_MMA(1, 1, At, B1); PG8_BAR; PG8_SCHED;
        }
        if (wr == 0) PG8_BAR;
        { Unit cur = uC; cur.par = ui & 1; E(acc, cur, wr, wc, fr, fq); }
        if (!has_next) break;
        { const bf16x8 zf = zero_frag();
#pragma unroll
        for (int a = 0; a < 2; ++a)
#pragma unroll
            for (int b = 0; b < 2; ++b)
#pragma unroll
                for (int m = 0; m < 4; m += 2) zero16(acc[a][b][m][0], acc[a][b][m][1], acc[a][b][m + 1][0], acc[a][b][m + 1][1], zf); }
        cA = nA; cB0 = nB0; cB1 = nB1; ++ui; uC = uN;
        PG8_ROWPF(rsN, ui);
        { Unit n1; has_next = PG8_NEXT(ui + 1, n1);
          if (has_next) { nA = (const char*)Ag + (size_t)n1.arow * rowA; nB0 = (const char*)Btg + (size_t)n1.brow0 * rowB; nB1 = (const char*)Btg + (size_t)n1.brow1 * rowB; if constexpr (Epi::ROWPF) rsN = (const char*)E.row_src(n1); uN = n1; }
          if constexpr (GATHER) {
#pragma unroll
            for (int _h = 0; _h < 2; ++_h) { vA[_h][0] = vN[_h][0]; vA[_h][1] = vN[_h][1]; }
            asm volatile("" : "+v"(vA[0][0]), "+v"(vA[0][1]), "+v"(vA[1][0]), "+v"(vA[1][1]));
            if (has_next) { PG8_GLOAD_ASM(vN, n1); } } }
        if (wr == 1) PG8_BAR;
    }
    PG8_WAIT_V(0);
    PG8_BAR;
#undef PG8_NEXT
#undef PG8_SA
#undef PG8_SB
#undef PG8_STAGE
#undef PG8_LDA
#undef PG8_LDB
#undef PG8_MMA
#undef PG8_WAIT_V
#undef PG8_WAIT_L
#undef PG8_BAR
#undef PG8_SCHED
#undef PG8_STG_A
#undef PG8_STG_B
#undef PG8_GLOAD
#undef PG8_GUSE
#undef PG8_ROWPF
#undef PG8_GLOAD_ASM
}
}

using pg8::Unit;
template <int NM, int NN> struct SchedPlain {
    int G, c;
    __device__ __forceinline__ bool next(int i, Unit& u) const { int pm, pn; if (!pg8::tile_order(i, c, G, NM, NN, pm, pn)) return false;
        u.arow = pm * 256; u.orow = pm * 256; u.brow0 = pn * 256; u.brow1 = pn * 256 + 128; u.pn = pn; u.aux = 0; u.nvalid = 256; return true; }
};
template <int NM, int NN, int OFF1> struct SchedPair {
    int G, c;
    __device__ __forceinline__ bool next(int i, Unit& u) const { int pm, pn; if (!pg8::tile_order(i, c, G, NM, NN, pm, pn)) return false;
        u.arow = pm * 256; u.orow = pm * 256; u.brow0 = pn * 128; u.brow1 = OFF1 + pn * 128; u.pn = pn; u.aux = 0; u.nvalid = 256; return true; }
};
struct SchedWin {
    int G, c;
    __device__ __forceinline__ bool next(int i, Unit& u) const { int pm, pn; if (!pg8::tile_order(i, c, G, NTOK / 256, 12, pm, pn)) return false;
        u.arow = pm * 256; u.orow = pm * 256; u.pn = pn; u.aux = 0; u.nvalid = 256;
        if (pn < 8) { u.brow0 = pn * 256; u.brow1 = pn * 256 + 128; } else { u.brow0 = 2048 + (pn - 8) * 128; u.brow1 = 2560 + (pn - 8) * 128; }
        return true; }
};
struct SchedS5A {
    int G, c;
    __device__ __forceinline__ bool next(int i, Unit& u) const { int pm, pn; if (!pg8::tile_order(i, c, G, SG * 8, 1, pm, pn)) return false;
        const int g = pm >> 3; u.arow = pm * 256; u.orow = pm * 256; u.brow0 = g * 256; u.brow1 = g * 256 + 128; u.pn = 0; u.aux = g; u.nvalid = 256; return true; }
};
struct SchedS5B {
    int G, c;
    __device__ __forceinline__ bool next(int i, Unit& u) const { int pm, pn; if (!pg8::tile_order(i, c, G, SG * 8, 2, pm, pn)) return false;
        const int g = pm >> 3; u.arow = pm * 256; u.orow = (pm & 7) * 256; u.brow0 = g * 512 + pn * 256; u.brow1 = u.brow0 + 128; u.pn = pn; u.aux = g; u.nvalid = 256; return true; }
};
constexpr int MOETAB_OFF = LDSCTL_OFF + 768;
__device__ __forceinline__ void moe_table(const Frame& F, const unsigned* gcnt) {
    if (F.tid < 8) ((LAS int*)(F.lds - RING_OFF + MOETAB_OFF))[F.tid] = (int)__hip_atomic_load(gcnt + F.tid, __ATOMIC_RELAXED, __HIP_MEMORY_SCOPE_AGENT);
    __syncthreads();
}
__device__ __forceinline__ int moe_tiles(const unsigned* gcnt) {
    int n = 0;
#pragma unroll
    for (int e = 0; e < 8; ++e) n += ((int)__builtin_amdgcn_readfirstlane((int)__hip_atomic_load(gcnt + e, __ATOMIC_RELAXED, __HIP_MEMORY_SCOPE_AGENT)) + 255) >> 8;
    return n;
}
template <int NN, int MODE> struct SchedMoe {
    int G, c, lbase  ;
    __device__ __forceinline__ bool next(int i, Unit& u) const {
        int cnt[8], nM = 0;
        unsigned z = 0; asm volatile("" : "+v"(z));
        volatile LAS int* tab = (volatile LAS int*)(LAS unsigned char*)(uintptr_t)(z + MOETAB_OFF);
#pragma unroll
        for (int e = 0; e < 8; ++e) { cnt[e] = __builtin_amdgcn_readfirstlane(tab[e]); nM += (cnt[e] + 255) >> 8; }
        int pm, pn, half = 0;
        if (MODE == 0) { if (!pg8::tile_order(i, c, G, nM, NN, pm, pn)) return false; }
        else { const int nwg = nM * NN, fullU = (nwg / G) * G; const int L = i * G + c;
            if (MODE == 1) { if (L >= fullU) return false; pg8::tile_order_L(L, nM, NN, pm, pn); }
            else { if (L >= 2 * (nwg - fullU)) return false; pg8::tile_order_L(fullU + (L >> 1), nM, NN, pm, pn); half = L & 1; } }
        int e = 0, mt = pm, ce = cnt[0];
#pragma unroll
        for (int k = 0; k < 7; ++k) { const int te = (cnt[k] + 255) >> 8; if (e == k && mt >= te) { mt -= te; e = k + 1; ce = cnt[k + 1]; } }
        const int nv = ce - mt * 256; u.nvalid = nv < 256 ? nv : 256; u.aux = lbase + e * NTOK + mt * 256; u.pn = pn; u.orow = pm * 256; u.eid = e;
        if (MODE == 0) { u.arow = u.aux; u.brow0 = e * (2 * DFE) + pn * 128; u.brow1 = u.brow0 + DFE; }
        else if (MODE == 1) { u.arow = pm * 256; u.brow0 = e * DM + pn * 256; u.brow1 = u.brow0 + 128; }
        else { u.arow = pm * 256; u.brow0 = e * DM + pn * 256 + half * 128; u.brow1 = u.brow0; u.pn = pn * 2 + half; }
        return true; }
};

#define EPI_ARGS const f32x4 (&acc)[2][2][4][2], const Unit& u, int wr, int wc, int fr, int fq
template <bool I8> struct EpiWin {
    static constexpr bool PERM = true, ROWPF = false;
    Frame F; int li;
    typedef typename std::conditional<I8, i32x4, f32x4>::type acc_t;
    static __device__ __forceinline__ f32x4 cv(const f32x4 a, float) { return a; }
    static __device__ __forceinline__ f32x4 cv(const i32x4 a, float s) { return (f32x4){(float)a[0], (float)a[1], (float)a[2], (float)a[3]} * s; }
    __device__ __forceinline__ void operator()(const acc_t (&acc)[2][2][4][2], const Unit& u, int wr, int wc, int fr, int fq) const {
        const int pn = u.pn, row0 = u.orow + wr * 64 + fr;
        unsigned char* big = WSP<unsigned char>(F, WS_BIG);
        const float* sat = WSP<const float>(F, WS_SHT); const float sbw = I8 ? WSP<const float>(F, WS_SB)[SBF_OFF + 8 + li] : 1.0f;
#define EW_RS(ai) float rsv[4]; _Pragma("unroll") for (int m = 0; m < 4; ++m) rsv[m] = I8 ? sat[row0 + (ai) * 128 + m * 16] * sbw : 1.0f
        if (pn < 8) {
            bf16_t* base = (bf16_t*)(big + (size_t)(pn >> 1) * (64 * MiB));
            const float* rope = WSP<float>(F, WS_ROPE);
            const int colt = (pn & 1) * 256 + wc * 32 + 8 * fq;
            const bool dorope = (pn < 4) && ((wc & 1) == 0) && (fq < 2);
            const float sc = pn < 2 ? QSCALE : 1.0f;
#pragma unroll
            for (int ai = 0; ai < 2; ++ai) {
                EW_RS(ai);
                f32x4 csv[4], snv[4];
#pragma unroll
                for (int m = 0; m < 4; ++m) { const int row = row0 + ai * 128 + m * 16; csv[m] = (f32x4){1.f, 1.f, 1.f, 1.f}; snv[m] = (f32x4){0.f, 0.f, 0.f, 0.f};
                    if (dorope) { csv[m] = *(const f32x4*)(rope + (size_t)row * 16 + 4 * fq); snv[m] = *(const f32x4*)(rope + (size_t)row * 16 + 8 + 4 * fq); } }
#pragma unroll
                for (int m = 0; m < 4; ++m) { const int row = row0 + ai * 128 + m * 16;
                    const f32x4 cs = csv[m], sn = snv[m];
#pragma unroll
                    for (int bj = 0; bj < 2; ++bj) { const f32x4 a0 = cv(acc[ai][bj][m][0], rsv[m]), a1 = cv(acc[ai][bj][m][1], rsv[m]);
                        const f32x4 v0 = (a0 * cs - a1 * sn) * sc, v1 = (a1 * cs + a0 * sn) * sc;
                        u32x4 w; w.x = cvt_pk_bf16(v0[0], v0[1]); w.y = cvt_pk_bf16(v0[2], v0[3]); w.z = cvt_pk_bf16(v1[0], v1[1]); w.w = cvt_pk_bf16(v1[2], v1[3]);
                        *(u32x4*)(base + (size_t)row * 512 + colt + bj * 128) = w; } } }
        } else {
            bf16_t* U = (bf16_t*)(big + BG_U);
            const int ch0 = (pn - 8) * 128 + wc * 32 + 8 * fq;
#pragma unroll
            for (int ai = 0; ai < 2; ++ai) { EW_RS(ai);
#pragma unroll
                for (int m = 0; m < 4; ++m) { const int row = row0 + ai * 128 + m * 16;
                    const float rs = rsv[m]; const f32x4 v0 = cv(acc[ai][0][m][0], rs) * cv(acc[ai][1][m][0], rs), v1 = cv(acc[ai][0][m][1], rs) * cv(acc[ai][1][m][1], rs);
                    u32x4 w; w.x = cvt_pk_bf16(v0[0], v0[1]); w.y = cvt_pk_bf16(v0[2], v0[3]); w.z = cvt_pk_bf16(v1[0], v1[1]); w.w = cvt_pk_bf16(v1[2], v1[3]);
                    *(u32x4*)(U + (size_t)row * 512 + ch0) = w; } }
        }
#undef EW_RS
    }
};
struct EpiRes {
    static constexpr bool PERM = true, ROWPF = false;
    Frame F; int base_is_x, gate_off, dry;
    __device__ __forceinline__ void operator()(EPI_ARGS) const {
        const int row0 = u.orow + wr * 64 + fr, col0 = u.pn * 256 + wc * 32 + 8 * fq, b = u.orow >> 12;
        bf16_t* out = WSP<bf16_t>(F, WS_XB); const float* xin = PT<const float>(F, P_X); const float* gate = WSP<const float>(F, WS_MOD) + gate_off;
#pragma unroll
        for (int bj = 0; bj < 2; ++bj) {
            const f32x4 g0 = *(const f32x4*)(gate + (size_t)b * 6144 + col0 + bj * 128), g1 = *(const f32x4*)(gate + (size_t)b * 6144 + col0 + bj * 128 + 4);
#pragma unroll
            for (int ai = 0; ai < 2; ++ai) {
                f32x4 bs[4][2];
#pragma unroll
                for (int m = 0; m < 4; ++m) { const size_t off = (size_t)(row0 + ai * 128 + m * 16) * DM + col0 + bj * 128;
                    if (base_is_x) { bs[m][0] = *(const f32x4*)(xin + off); bs[m][1] = *(const f32x4*)(xin + off + 4); }
                    else { const u32x4 w = *(const u32x4*)(out + off); bs[m][0] = (f32x4){bf_lo(w.x), bf_hi(w.x), bf_lo(w.y), bf_hi(w.y)}; bs[m][1] = (f32x4){bf_lo(w.z), bf_hi(w.z), bf_lo(w.w), bf_hi(w.w)}; } }
#pragma unroll
                for (int m = 0; m < 4; ++m) { const size_t off = (size_t)(row0 + ai * 128 + m * 16) * DM + col0 + bj * 128;
                    const f32x4 v0 = bs[m][0] + g0 * acc[ai][bj][m][0], v1 = bs[m][1] + g1 * acc[ai][bj][m][1];
                    u32x4 o; o.x = cvt_pk_bf16(v0.x, v0.y); o.y = cvt_pk_bf16(v0.z, v0.w); o.z = cvt_pk_bf16(v1.x, v1.y); o.w = cvt_pk_bf16(v1.z, v1.w);
                    if (!dry) *(u32x4*)(out + off) = o; }
                asm volatile("" ::: "memory"); } }
    }
};
struct EpiResI8 {
    static constexpr bool PERM = true, ROWPF = false;
    Frame F; int gate_off, li, dry;
    __device__ __forceinline__ void operator()(const i32x4 (&acc)[2][2][4][2], const Unit& u, int wr, int wc, int fr, int fq) const {
        const int row0 = u.orow + wr * 64 + fr, col0 = u.pn * 256 + wc * 32 + 8 * fq, b = u.orow >> 12;
        bf16_t* out = WSP<bf16_t>(F, WS_XB); const float* gate = WSP<const float>(F, WS_MOD) + gate_off; const float* sht = WSP<const float>(F, WS_SHT); const float sbd = WSP<const float>(F, WS_SB)[SBF_OFF + 3 * li + 2];
        f32x4 gv[2][2];
#pragma unroll
        for (int bj = 0; bj < 2; ++bj)
#pragma unroll
            for (int n = 0; n < 2; ++n) gv[bj][n] = *(const f32x4*)(gate + (size_t)b * 6144 + col0 + bj * 128 + n * 4) * sbd;
        float shv[2][4];
#pragma unroll
        for (int ai = 0; ai < 2; ++ai)
#pragma unroll
            for (int m = 0; m < 4; ++m) shv[ai][m] = sht[row0 + ai * 128 + m * 16];
#pragma unroll
        for (int ai = 0; ai < 2; ++ai) {
            u32x4 bs[4][2];
#pragma unroll
            for (int m = 0; m < 4; ++m)
#pragma unroll
                for (int bj = 0; bj < 2; ++bj) bs[m][bj] = *(const u32x4*)(out + (size_t)(row0 + ai * 128 + m * 16) * DM + col0 + bj * 128);
#pragma unroll
            for (int m = 0; m < 4; ++m) { const float sh = shv[ai][m];
#pragma unroll
                for (int bj = 0; bj < 2; ++bj) { const u32x4 w = bs[m][bj]; u32x4 o;
#pragma unroll
                    for (int n = 0; n < 2; ++n) { const f32x4 b4 = (f32x4){bf_lo(w[2 * n]), bf_hi(w[2 * n]), bf_lo(w[2 * n + 1]), bf_hi(w[2 * n + 1])}; const i32x4 a = acc[ai][bj][m][n]; const f32x4 af = (f32x4){(float)a[0], (float)a[1], (float)a[2], (float)a[3]};
                        const f32x4 v = b4 + (gv[bj][n] * sh) * af; o[2 * n] = cvt_pk_bf16(v.x, v.y); o[2 * n + 1] = cvt_pk_bf16(v.z, v.w); }
                    if (!dry) *(u32x4*)(out + (size_t)(row0 + ai * 128 + m * 16) * DM + col0 + bj * 128) = o; } }
            asm volatile("" ::: "memory"); }
    }
};
template <int LDH> struct EpiAct {
    static constexpr bool PERM = true, ROWPF = false;
    Frame F; int dry;
    __device__ __forceinline__ void operator()(EPI_ARGS) const {
        bf16_t* hid = WSP<bf16_t>(F, WS_BIG + BG_HID);
        const int row0 = u.orow + wr * 64 + fr, ch0 = u.pn * 128 + wc * 32 + 8 * fq;
#pragma unroll
        for (int ai = 0; ai < 2; ++ai)
#pragma unroll
            for (int m = 0; m < 4; ++m) { f32x4 v[2];
#pragma unroll
                for (int n = 0; n < 2; ++n) { const f32x4 gt = acc[ai][0][m][n], up = acc[ai][1][m][n];
#pragma unroll
                    for (int j = 0; j < 4; ++j) v[n][j] = silu_f(gt[j]) * up[j]; }
                u32x4 w; w.x = cvt_pk_bf16(v[0][0], v[0][1]); w.y = cvt_pk_bf16(v[0][2], v[0][3]); w.z = cvt_pk_bf16(v[1][0], v[1][1]); w.w = cvt_pk_bf16(v[1][2], v[1][3]);
                if (!dry) *(u32x4*)(hid + (size_t)(row0 + ai * 128 + m * 16) * LDH + ch0) = w; }
    }
};
template <int LDH, bool MOE, bool OUT8> struct EpiActI8 {
    static constexpr bool PERM = true, ROWPF = true;
    Frame F; int dry, li, slot;
    __device__ __forceinline__ const void* row_src(const Unit& u) const { return MOE ? (const void*)(WSP<const f32x2>(F, WS_SCL) + u.aux) : (const void*)(WSP<const f32x2>(F, WS_SCT) + u.orow); }
    __device__ __forceinline__ void operator()(const i32x4 (&acc)[2][2][4][2], const Unit& u, int wr, int wc, int fr, int fq) const {
        signed char* hid = WSP<signed char>(F, WS_BIG + BG_HID) + (size_t)slot * HID_SLOT;
        const LAS f32x2* rowbuf = (const LAS f32x2*)(F.lds - RING_OFF + ROWBUF_OFF + u.par * 2048);
        const int row0 = u.orow + wr * 64 + fr, ch0 = u.pn * 128 + wc * 32 + 8 * fq;
#pragma unroll
        for (int ai = 0; ai < 2; ++ai)
#pragma unroll
            for (int m = 0; m < 4; ++m) { const int r = ai * 128 + wr * 64 + m * 16 + fr; const f32x2 rs = rowbuf[r]; const float sgl = rs.x, cc = OUT8 ? rs.y * Q8N : rs.y, icc = fast_rcp(cc); f32x4 v[2]; const f32x2 q8h2 = (f32x2){Q8H, Q8H};
                const f32x2 sgl2 = (f32x2){sgl, sgl}, icc2 = (f32x2){icc, icc};
#pragma unroll
                for (int n = 0; n < 2; ++n) { const i32x4 gt = acc[ai][0][m][n], up = acc[ai][1][m][n];
#pragma unroll
                    for (int j = 0; j < 4; j += 2) { const f32x2 gi = (f32x2){(float)gt[j], (float)gt[j + 1]}, ui = (f32x2){(float)up[j], (float)up[j + 1]};
                        const f32x2 t = gi * sgl2; const f32x2 d = (f32x2){fast_exp2(t.x), fast_exp2(t.y)} * icc2 + icc2; const f32x2 r = (f32x2){fast_rcp(d.x), fast_rcp(d.y)};
                        const f32x2 o = OUT8 ? (gi * ui) * r + q8h2 : (gi * ui) * r; v[n][j] = o.x; v[n][j + 1] = o.y; } }
                if constexpr (OUT8) { u32x2 w; w.x = q8hi(v[0][0], v[0][1], v[0][2], v[0][3]); w.y = q8hi(v[1][0], v[1][1], v[1][2], v[1][3]);
                    if (!dry) *(u32x2*)(hid + (size_t)(row0 + ai * 128 + m * 16) * LDH + ch0) = w; }
                else { u32x4 w; w.x = cvt_pk_bf16(v[0][0], v[0][1]); w.y = cvt_pk_bf16(v[0][2], v[0][3]); w.z = cvt_pk_bf16(v[1][0], v[1][1]); w.w = cvt_pk_bf16(v[1][2], v[1][3]);
                    if (!dry) *(u32x4*)((bf16_t*)hid + (size_t)(row0 + ai * 128 + m * 16) * LDH + ch0) = w; } }
    }
};
struct EpiS5A {
    static constexpr bool PERM = false, ROWPF = false;
    Frame F;
    __device__ __forceinline__ void operator()(EPI_ARGS) const {
        float* S = WSP<float>(F, WS_BIG + BG_S);
        const int row0 = u.orow + wr * 64 + fr, col0 = wc * 32 + 4 * fq;
#pragma unroll
        for (int ai = 0; ai < 2; ++ai)
#pragma unroll
            for (int m = 0; m < 4; ++m)
#pragma unroll
                for (int n = 0; n < 2; ++n) *(f32x4*)(S + (size_t)(row0 + ai * 128 + m * 16) * 128 + col0 + n * 16) = acc[ai][0][m][n];
    }
};
struct EpiS5B {
    static constexpr bool PERM = true, ROWPF = false;
    Frame F;
    __device__ __forceinline__ void operator()(EPI_ARGS) const {
        bf16_t* gact = WSP<bf16_t>(F, WS_H);
        const int g = u.aux, c0 = 8 * (fq & 1);
        const unsigned colbase = (unsigned)(g * 16 + c0) + (unsigned)(16 * u.pn + 2 * wc + (fq >> 1)) * DM;
#pragma unroll
        for (int ai = 0; ai < 2; ++ai)
#pragma unroll
            for (int m = 0; m < 4; ++m) { const int ridx = u.orow + ai * 128 + wr * 64 + m * 16 + fr; const int b = ridx >> 7, ch = ridx & 127;
                const unsigned tok0 = (unsigned)(b * SEQ + ch * SL);
#pragma unroll
                for (int bj = 0; bj < 2; ++bj) {
                    const f32x4 a0 = acc[ai][bj][m][0], a1 = acc[ai][bj][m][1]; f32x4 v0, v1;
#pragma unroll
                    for (int j = 0; j < 4; j += 2) { const f32x2 g0 = gelu_tanh_2((f32x2){a0[j], a0[j + 1]}), g1 = gelu_tanh_2((f32x2){a1[j], a1[j + 1]}); v0[j] = g0.x; v0[j + 1] = g0.y; v1[j] = g1.x; v1[j + 1] = g1.y; }
                    u32x4 w; w.x = cvt_pk_bf16(v0[0], v0[1]); w.y = cvt_pk_bf16(v0[2], v0[3]); w.z = cvt_pk_bf16(v1[0], v1[1]); w.w = cvt_pk_bf16(v1[2], v1[3]);
                    *(u32x4*)(gact + (size_t)(tok0 * DM + colbase + (unsigned)(8 * bj) * DM)) = w; } }
    }
};
struct EpiGlu {
    static constexpr bool PERM = true, ROWPF = false;
    Frame F; int gate_off, li, dry;
    __device__ __forceinline__ void operator()(EPI_ARGS) const {
        bf16_t* out = WSP<bf16_t>(F, WS_XB); const float* gate = WSP<const float>(F, WS_MOD) + gate_off; const float* bias = PT<const float>(F, P_GLUB) + (size_t)li * 2 * DM;
        const int row0 = u.orow + wr * 64 + fr, ch0 = u.pn * 128 + wc * 32 + 8 * fq, b = u.orow >> 12;
        f32x4 gv[2], bv[2], bg[2];
#pragma unroll
        for (int n = 0; n < 2; ++n) { gv[n] = *(const f32x4*)(gate + (size_t)b * 6144 + ch0 + 4 * n); bv[n] = *(const f32x4*)(bias + ch0 + 4 * n); bg[n] = *(const f32x4*)(bias + DM + ch0 + 4 * n) * (-LOG2E); }
        u32x4 bs[2][4];
#pragma unroll
        for (int ai = 0; ai < 2; ++ai)
#pragma unroll
            for (int m = 0; m < 4; ++m) bs[ai][m] = *(const u32x4*)(out + (size_t)(row0 + ai * 128 + m * 16) * DM + ch0);
#pragma unroll
        for (int ai = 0; ai < 2; ++ai)
#pragma unroll
            for (int m = 0; m < 4; ++m) { const size_t off = (size_t)(row0 + ai * 128 + m * 16) * DM + ch0; const u32x4 w = bs[ai][m]; f32x4 o[2];
#pragma unroll
                for (int n = 0; n < 2; ++n) { const f32x4 va = acc[ai][0][m][n] + bv[n], ga = acc[ai][1][m][n], bl = bg[n]; f32x4 mix;
#pragma unroll
                    for (int j = 0; j < 4; j += 2) { const f32x2 t = (f32x2){ga[j], ga[j + 1]} * (f32x2){-LOG2E, -LOG2E} + (f32x2){bl[j], bl[j + 1]};
                        const f32x2 d = (f32x2){fast_exp2(t.x), fast_exp2(t.y)} + (f32x2){1.0f, 1.0f}; const f32x2 mx = (f32x2){va[j], va[j + 1]} * (f32x2){fast_rcp(d.x), fast_rcp(d.y)}; mix[j] = mx.x; mix[j + 1] = mx.y; }
                    const f32x4 b4 = (f32x4){bf_lo(w[2 * n]), bf_hi(w[2 * n]), bf_lo(w[2 * n + 1]), bf_hi(w[2 * n + 1])}; o[n] = b4 + gv[n] * mix; }
                u32x4 ow; ow.x = cvt_pk_bf16(o[0].x, o[0].y); ow.y = cvt_pk_bf16(o[0].z, o[0].w); ow.z = cvt_pk_bf16(o[1].x, o[1].y); ow.w = cvt_pk_bf16(o[1].z, o[1].w);
                if (!dry) *(u32x4*)(out + off) = ow; }
    }
};
struct EpiMoeDown {
    static constexpr bool PERM = false, ROWPF = false;
    Frame F; int gate_off, dry;
    __device__ __forceinline__ void operator()(EPI_ARGS) const {
        bf16_t* x = WSP<bf16_t>(F, WS_XB); const float* gate = WSP<const float>(F, WS_MOD) + gate_off; const int* list = WSP<const int>(F, WS_LIST); const float* gatew = WSP<const float>(F, WS_GATEW);
        const int col0 = u.pn * 256 + wc * 32 + 4 * fq;
#pragma unroll
        for (int ai = 0; ai < 2; ++ai)
#pragma unroll
            for (int m = 0; m < 4; ++m) { const int r = ai * 128 + wr * 64 + m * 16 + fr;
                if (r < u.nvalid) { const int tok = list[u.aux + r]; const float gw = gatew[u.aux + r]; const int b = tok >> 12; const size_t off = (size_t)tok * DM + col0;
#pragma unroll
                    for (int bj = 0; bj < 2; ++bj)
#pragma unroll
                        for (int n = 0; n < 2; ++n) { const f32x4 gv = *(const f32x4*)(gate + (size_t)b * 6144 + col0 + bj * 128 + n * 16); const f32x4 bs = xb_ld4(x + off + bj * 128 + n * 16);
                            if (!dry) xb_st4(x + off + bj * 128 + n * 16, bs + (gv * gw) * acc[ai][bj][m][n]); } }
                asm volatile("" ::: "memory"); }
    }
};

template <bool HALFU> struct EpiMoeDownI8 {
    static constexpr bool PERM = true, ROWPF = true;
    Frame F; int L, dry;
    __device__ __forceinline__ const void* row_src(const Unit& u) const { return (const void*)(WSP<const f32x2>(F, WS_REC) + u.aux); }
    __device__ __forceinline__ void operator()(const i32x4 (&acc)[2][2][4][2], const Unit& u, int wr, int wc, int fr, int fq) const {
        bf16_t* x = WSP<bf16_t>(F, WS_XB); const bf16_t* gateb = WSP<const bf16_t>(F, WS_GATEB) + (size_t)L * 16 * 1024;
        const float sbd = WSP<const float>(F, WS_SB)[16 + u.eid];
        const LAS f32x2* rowbuf = (const LAS f32x2*)(F.lds - RING_OFF + ROWBUF_OFF + u.par * 2048);
        const int col0 = (HALFU ? u.pn * 128 : u.pn * 256) + wc * 32 + 8 * fq;
        constexpr int NBJ = HALFU ? 1 : 2;
#pragma unroll
        for (int ai = 0; ai < 2; ++ai) {
            int tokv[4]; float cwv[4];
#pragma unroll
            for (int m = 0; m < 4; ++m) { const int r = ai * 128 + wr * 64 + m * 16 + fr; const f32x2 rc = rowbuf[r < u.nvalid ? r : u.nvalid - 1];
                tokv[m] = __float_as_int(rc.x); cwv[m] = rc.y * sbd; }
#pragma unroll
            for (int bj = 0; bj < NBJ; ++bj) {
                u32x4 bs[4], gq[4];
#pragma unroll
                for (int m = 0; m < 4; ++m) { const int tok = tokv[m]; bs[m] = *(const u32x4*)(x + (size_t)tok * DM + col0 + bj * 128); gq[m] = *(const u32x4*)(gateb + (size_t)(tok >> 12) * 1024 + col0 + bj * 128); }
#pragma unroll
                for (int m = 0; m < 4; ++m) { const int r = ai * 128 + wr * 64 + m * 16 + fr; const size_t off = (size_t)tokv[m] * DM + col0 + bj * 128; const float cw = cwv[m];
                    if (r < u.nvalid && !dry) { const u32x4 w = bs[m], g = gq[m]; u32x4 o;
#pragma unroll
                        for (int n = 0; n < 2; ++n) { const f32x4 b4 = (f32x4){bf_lo(w[2 * n]), bf_hi(w[2 * n]), bf_lo(w[2 * n + 1]), bf_hi(w[2 * n + 1])}, g4 = (f32x4){bf_lo(g[2 * n]), bf_hi(g[2 * n]), bf_lo(g[2 * n + 1]), bf_hi(g[2 * n + 1])};
                            const i32x4 a = acc[ai][bj][m][n]; const f32x4 af = (f32x4){(float)a[0], (float)a[1], (float)a[2], (float)a[3]}; const f32x4 v = b4 + (g4 * cw) * af;
                            o[2 * n] = cvt_pk_bf16(v.x, v.y); o[2 * n + 1] = cvt_pk_bf16(v.z, v.w); }
                        *(u32x4*)(x + off) = o; } }
                asm volatile("" ::: "memory"); } }
    }
};

__device__ __forceinline__ void conv_item(const float* W, int K, int N, bf16_t* Wt, int ldt, int row_off, LAS float* scr, int item, int lane, int mode) {
    const int nblk = N / 64, kb = item / nblk, nb = item - kb * nblk, k0 = 64 * kb, n0 = 64 * nb;
    const int kr = lane >> 4, nq = lane & 15;
    int nqd = nq;
    if (mode == 1 && n0 < 1024) nqd = (nq == 1) ? 2 : ((nq == 2) ? 1 : nq);
    f32x4 v[16];
    const float* src = W + (size_t)(k0 + kr) * N + n0 + 4 * nq;
#pragma unroll
    for (int i = 0; i < 16; ++i) v[i] = *(const f32x4*)(src + (size_t)(4 * i) * N);
#pragma unroll
    for (int i = 0; i < 16; ++i) { const int kk = 4 * i + kr; int kd = kk;
        if (mode == 2 && k0 < 512) { const int blk = kk >> 5, d5 = kk & 31; kd = ((d5 >> 2) & 1) * 32 + blk * 16 + (d5 & 3) + 4 * (d5 >> 3); }
        *(LAS f32x4*)(scr + kd * 64 + ((4 * nqd) ^ ((kd >> 3) << 3))) = v[i]; }
    LDS_WAIT(); asm volatile("" ::: "memory");
    const int c = lane & 7;
#pragma unroll
    for (int j = 0; j < 8; ++j) { const int n = (lane >> 3) + 8 * j; const LAS float* sp = scr + (8 * c) * 64 + (n ^ (c << 3));
        u32x4 o; o.x = cvt_pk_bf16(sp[0 * 64], sp[1 * 64]); o.y = cvt_pk_bf16(sp[2 * 64], sp[3 * 64]); o.z = cvt_pk_bf16(sp[4 * 64], sp[5 * 64]); o.w = cvt_pk_bf16(sp[6 * 64], sp[7 * 64]);
        *(u32x4*)(Wt + (size_t)(row_off + n0 + n) * ldt + k0 + 8 * c) = o; }
    LDS_WAIT(); asm volatile("" ::: "memory");
}

template <int Q8, bool XF32> __device__ __forceinline__ void norm_plain(const Frame& F, const void* xv, const float* ng, const float* mod_sh, const float* mod_sc, bf16_t* H, float* SAT, float* SHT, const float* sbf) {
    const int gw = F.bx * 8 + F.wave, NGW = F.G * 8;
    for (int rb = gw; rb < NTOK / 32; rb += NGW) {
        const int b = rb >> 7;
        f32x4 gs[4], sh[4];
#pragma unroll
        for (int j = 0; j < 4; ++j) { const int col = 256 * j + 4 * F.lane; const f32x4 g4 = *(const f32x4*)(ng + col), s4 = *(const f32x4*)(mod_sc + (size_t)b * 6144 + col);
            gs[j] = g4 * (s4 + 1.0f); sh[j] = *(const f32x4*)(mod_sh + (size_t)b * 6144 + col); }
        const float* x = (const float*)xv; const bf16_t* xb = (const bf16_t*)xv;
        f32x4 nx[2][4];
        { const size_t e0 = (size_t)rb * 32 * DM + 4 * F.lane;
#pragma unroll
          for (int q = 0; q < 2; ++q)
#pragma unroll
              for (int j = 0; j < 4; ++j) nx[q][j] = XF32 ? *(const f32x4*)(x + e0 + q * DM + 256 * j) : xb_ld4(xb + e0 + q * DM + 256 * j); }
#pragma unroll 2
        for (int rr = 0; rr < 32; rr += 2) { const size_t row = (size_t)rb * 32 + rr;
            f32x4 v[2][4]; float ss[2] = {0.f, 0.f};
#pragma unroll
            for (int q = 0; q < 2; ++q)
#pragma unroll
                for (int j = 0; j < 4; ++j) v[q][j] = nx[q][j];
            if (rr + 2 < 32) { const size_t e0 = (row + 2) * DM + 4 * F.lane;
#pragma unroll
                for (int q = 0; q < 2; ++q)
#pragma unroll
                    for (int j = 0; j < 4; ++j) nx[q][j] = XF32 ? *(const f32x4*)(x + e0 + q * DM + 256 * j) : xb_ld4(xb + e0 + q * DM + 256 * j); }
#pragma unroll
            for (int q = 0; q < 2; ++q)
#pragma unroll
                for (int j = 0; j < 4; ++j) ss[q] += (v[q][j].x * v[q][j].x + v[q][j].y * v[q][j].y) + (v[q][j].z * v[q][j].z + v[q][j].w * v[q][j].w);
#pragma unroll
            for (int q = 0; q < 2; ++q) { const float rstd = fast_rsq(wave_sum(ss[q]) * (1.0f / DM) + RMS_EPS);
                if constexpr (!Q8) { u32x2* o8 = (u32x2*)(H + (row + q) * DM) + F.lane;
#pragma unroll
                    for (int j = 0; j < 4; ++j) { const f32x4 h = v[q][j] * rstd * gs[j] + sh[j]; u32x2 w; w.x = cvt_pk_bf16(h.x, h.y); w.y = cvt_pk_bf16(h.z, h.w); o8[64 * j] = w; }
                } else { float amax = 0.f, hn2 = 0.f;
#pragma unroll
                    for (int j = 0; j < 4; ++j) { const f32x4 h = v[q][j] * rstd * gs[j] + sh[j]; v[q][j] = h; amax = amax3(amax3(amax, h.x, h.y), h.z, h.w); hn2 += (h.x * h.x + h.y * h.y) + (h.z * h.z + h.w * h.w); }
                    amax = wave_max(amax);
                    hn2 = wave_sum(hn2);
                    const float qs = amax > 0.f ? 127.0f * fast_rcp(amax) : 0.f; unsigned* q8 = (unsigned*)((signed char*)H + (row + q) * DM) + F.lane;
#pragma unroll
                    for (int j = 0; j < 4; ++j) q8[64 * j] = q8pack(v[q][j].x, v[q][j].y, v[q][j].z, v[q][j].w, qs);
                    if constexpr (Q8 == 2) { if (F.lane == 0) SHT[row + q] = amax * (1.0f / 127.0f); }
                    else if (F.lane == 0) { const float sa_ = amax * (1.0f / 127.0f), sht_ = fmaxf(QH * hn2 * (sbf[0] * (127.0f / WQ)) * (sbf[1] * (127.0f / WQ)), 1e-20f) * (1.0f / 127.0f), sg = sa_ * sbf[0], su = sa_ * sbf[1];
                        SHT[row + q] = sht_; ((f32x2*)SAT)[row + q] = (f32x2){-sg * LOG2E, sg * su / sht_}; } } } }
    }
}
__device__ __forceinline__ void norm_s5(const Frame& F, const bf16_t* x, const float* ng, const float* mod_sh, const float* mod_sc, bf16_t* HG) {
    const int gw = F.bx * 8 + F.wave, NGW = F.G * 8, lane = F.lane;
    LAS unsigned char* scr = F.lds + F.wave * 16384;
    for (int rb = gw; rb < NTOK / 32; rb += NGW) {
        const int b = rb >> 7, chunk = rb & 127;
        f32x4 gs[4], sh[4];
#pragma unroll
        for (int j = 0; j < 4; ++j) { const int col = 16 * lane + 4 * j; const f32x4 g4 = *(const f32x4*)(ng + col), s4 = *(const f32x4*)(mod_sc + (size_t)b * 6144 + col);
            gs[j] = g4 * (s4 + 1.0f); sh[j] = *(const f32x4*)(mod_sh + (size_t)b * 6144 + col); }
        u32x4 nx[2][2];
#pragma unroll
        for (int q = 0; q < 2; ++q)
#pragma unroll
            for (int j = 0; j < 2; ++j) nx[q][j] = *(const u32x4*)(x + ((size_t)rb * 32 + q) * DM + 16 * lane + 8 * j);
        for (int r8 = 0; r8 < 4; ++r8) {
#pragma unroll 2
            for (int jt = 0; jt < 8; ++jt) { const int rr = r8 * 8 + jt; const size_t row = (size_t)rb * 32 + rr;
                f32x4 v[4]; float ss = 0.f;
                { const u32x4 a = nx[0][0], c = nx[0][1]; nx[0][0] = nx[1][0]; nx[0][1] = nx[1][1];
                  v[0] = (f32x4){bf_lo(a.x), bf_hi(a.x), bf_lo(a.y), bf_hi(a.y)}; v[1] = (f32x4){bf_lo(a.z), bf_hi(a.z), bf_lo(a.w), bf_hi(a.w)};
                  v[2] = (f32x4){bf_lo(c.x), bf_hi(c.x), bf_lo(c.y), bf_hi(c.y)}; v[3] = (f32x4){bf_lo(c.z), bf_hi(c.z), bf_lo(c.w), bf_hi(c.w)}; }
#pragma unroll
                for (int j = 0; j < 4; ++j) ss += (v[j].x * v[j].x + v[j].y * v[j].y) + (v[j].z * v[j].z + v[j].w * v[j].w);
                if (rr + 2 < 32) {
#pragma unroll
                    for (int j = 0; j < 2; ++j) nx[1][j] = *(const u32x4*)(x + (row + 2) * DM + 16 * lane + 8 * j); }
                const float rstd = fast_rsq(wave_sum(ss) * (1.0f / DM) + RMS_EPS);
                u32x4 w0, w1; f32x4 h;
                h = v[0] * rstd * gs[0] + sh[0]; w0.x = cvt_pk_bf16(h.x, h.y); w0.y = cvt_pk_bf16(h.z, h.w);
                h = v[1] * rstd * gs[1] + sh[1]; w0.z = cvt_pk_bf16(h.x, h.y); w0.w = cvt_pk_bf16(h.z, h.w);
                h = v[2] * rstd * gs[2] + sh[2]; w1.x = cvt_pk_bf16(h.x, h.y); w1.y = cvt_pk_bf16(h.z, h.w);
                h = v[3] * rstd * gs[3] + sh[3]; w1.z = cvt_pk_bf16(h.x, h.y); w1.w = cvt_pk_bf16(h.z, h.w);
                const int key = lane & 15;
                *(LAS u32x4*)(scr + lane * 256 + (((2 * jt) ^ key) << 4)) = w0; *(LAS u32x4*)(scr + lane * 256 + (((2 * jt + 1) ^ key) << 4)) = w1; }
            LDS_WAIT(); asm volatile("" ::: "memory");
            { const int c = lane & 15, rsub = lane >> 4;
#pragma unroll
              for (int q = 0; q < 16; ++q) { const int g = 4 * q + rsub; const u32x4 wv = *(const LAS u32x4*)(scr + g * 256 + ((c ^ (g & 15)) << 4));
                  *(u32x4*)(HG + ((size_t)g * S5ROWS + b * NCHUNK + chunk) * S5K + r8 * 128 + c * 8) = wv; } }
            LDS_WAIT(); asm volatile("" ::: "memory");
        }
    }
}
__device__ __forceinline__ void norm_final(const Frame& F, const bf16_t* x, float* out, const float* ng) {
    const int gw = F.bx * 8 + F.wave, NGW = F.G * 8;
    f32x4 gs[4];
#pragma unroll
    for (int j = 0; j < 4; ++j) gs[j] = *(const f32x4*)(ng + 256 * j + 4 * F.lane);
    f32x4 nx[2][4];
#pragma unroll
    for (int q = 0; q < 2; ++q)
#pragma unroll
        for (int j = 0; j < 4; ++j) nx[q][j] = xb_ld4(x + ((size_t)gw + (size_t)q * NGW) * DM + 256 * j + 4 * F.lane);
    for (size_t row = gw; row < (size_t)NTOK; row += NGW) {
        f32x4* xr = (f32x4*)(out + row * DM) + F.lane; f32x4 v[4]; float ss = 0.f;
#pragma unroll
        for (int j = 0; j < 4; ++j) { v[j] = nx[0][j]; nx[0][j] = nx[1][j]; ss += (v[j].x * v[j].x + v[j].y * v[j].y) + (v[j].z * v[j].z + v[j].w * v[j].w); }
        if (row + 2 * (size_t)NGW < (size_t)NTOK) {
#pragma unroll
            for (int j = 0; j < 4; ++j) nx[1][j] = xb_ld4(x + (row + 2 * (size_t)NGW) * DM + 256 * j + 4 * F.lane); }
        const float rstd = fast_rsq(wave_sum(ss) * (1.0f / DM) + RMS_EPS);
#pragma unroll
        for (int j = 0; j < 4; ++j) xr[64 * j] = v[j] * rstd * gs[j];
    }
}

constexpr int AT_KPITCH = 144, AT_VPITCH = 784, AT_KBYTES = 384 * AT_KPITCH, AT_VBYTES = 64 * AT_VPITCH;
constexpr int AT_UNITS = NB * NH * 48;
__device__ __forceinline__ int crow(int r, int hi) { return (r & 3) + 8 * (r >> 2) + 4 * hi; }
__device__ __forceinline__ float max3f(float a, float b, float c) { float r; asm("v_max3_f32 %0, %1, %2, %3" : "=v"(r) : "v"(a), "v"(b), "v"(c)); return r; }
__device__ __forceinline__ float swap32(float v) { auto r = __builtin_amdgcn_permlane32_swap(__float_as_uint(v), __float_as_uint(v), false, false); return __uint_as_float(__builtin_amdgcn_mbcnt_hi(~0u, __builtin_amdgcn_mbcnt_lo(~0u, 0u)) < 32 ? r[1] : r[0]); }
struct AttnUnitDesc { int b, h, br, dsh, r, nb; };
__device__ __forceinline__ AttnUnitDesc attn_unit_desc(int un) {
    AttnUnitDesc d; const int bh = un / 48, u48 = un - bh * 48, idx = u48 & 15; d.br = u48 >> 4; d.dsh = 2 * d.br;
    d.r = (d.br == 0) ? 0 : ((d.br == 1) ? (idx & 3) : idx); d.nb = (d.br == 0) ? idx : ((d.br == 1) ? (idx >> 2) : 0); d.b = bh >> 3; d.h = bh & 7; return d;
}
__device__ __forceinline__ void attn_phase(const Frame& F, const bf16_t* Qb, const bf16_t* Kb, const bf16_t* Vb, bf16_t* OB, float* LSE) {
    LAS unsigned char* KS = F.lds; LAS unsigned char* VT = F.lds + AT_KBYTES;
    const int tid = F.tid, lane = F.lane, wid = F.wave, r32 = lane & 31, hi = lane >> 5;
    const int per = (AT_UNITS + F.G - 1) / F.G;
    const int u_lo = F.bx * per, u_hi = (u_lo + per < AT_UNITS) ? u_lo + per : AT_UNITS;
    if (u_lo >= u_hi) return;
    const bool xcdmap = (F.G == 256);
    const int xc = F.bx & 7, rk = F.bx >> 3;
#define AT_UNIT(i_) (xcdmap ? ((xc * 16 + 2 * ((i_) / 3)) * 48 + rk + 32 * ((i_) % 3)) : (u_lo + (i_)))
    u32x4 kreg[6], vreg[2][4];
#define AT_LOAD(un_) do { const AttnUnitDesc d_ = attn_unit_desc(un_); const int jb_ = d_.nb * 256 - 128; const size_t tokb_ = (size_t)d_.b * SEQ; \
        _Pragma("unroll") for (int k = 0; k < 6; ++k) { const int c = tid + 512 * k, row = c >> 3, cc = c & 7, j = jb_ + row; kreg[k] = (u32x4){0u, 0u, 0u, 0u}; \
            if (j >= 0) kreg[k] = *(const u32x4*)(Kb + (tokb_ + d_.r + ((size_t)j << d_.dsh)) * AW + d_.h * 64 + cc * 8); } \
        _Pragma("unroll") for (int it = 0; it < 2; ++it) { const int item = tid + 512 * it, kq = item >> 3, dc = item & 7; \
            _Pragma("unroll") for (int e = 0; e < 4; ++e) { const int j = jb_ + 4 * kq + e; vreg[it][e] = (u32x4){0u, 0u, 0u, 0u}; \
                if (item < 768 && j >= 0) vreg[it][e] = *(const u32x4*)(Vb + (tokb_ + d_.r + ((size_t)j << d_.dsh)) * AW + d_.h * 64 + dc * 8); } } \
        } while (0)
    AT_LOAD(AT_UNIT(0));
    for (int ui_ = 0; ui_ < u_hi - u_lo; ++ui_) { const int un = AT_UNIT(ui_);
        const AttnUnitDesc d = attn_unit_desc(un);
        const int br = d.br, nb = d.nb, h = d.h;
        const size_t qtok = (size_t)d.b * SEQ + d.r + ((size_t)(nb * 256 + 32 * wid + r32) << d.dsh);
        bf16x8 qc[4];
#pragma unroll
        for (int d0 = 0; d0 < 4; ++d0) qc[d0] = *(const bf16x8*)(Qb + qtok * AW + h * 64 + 16 * d0 + 8 * hi);
#pragma unroll
        for (int k = 0; k < 6; ++k) { const int c = tid + 512 * k, row = c >> 3, cc = c & 7; *(LAS u32x4*)(KS + row * AT_KPITCH + cc * 16) = kreg[k]; }
#pragma unroll
        for (int it = 0; it < 2; ++it) { const int item = tid + 512 * it, kq = item >> 3, dc = item & 7;
            if (item < 768) { const int g16 = kq >> 2, cq = kq & 3, cperm = ((cq & 1) << 1) | (cq >> 1);
#pragma unroll
                for (int jj = 0; jj < 8; ++jj) { const int w = jj >> 1; unsigned e0 = vreg[it][0][w], e1 = vreg[it][1][w], e2 = vreg[it][2][w], e3 = vreg[it][3][w];
                    u32x2 o;
                    if (jj & 1) { o.x = (e0 >> 16) | (e1 & 0xffff0000u); o.y = (e2 >> 16) | (e3 & 0xffff0000u); }
                    else { o.x = (e0 & 0xffffu) | (e1 << 16); o.y = (e2 & 0xffffu) | (e3 << 16); }
                    *(LAS u32x2*)(VT + (dc * 8 + jj) * AT_VPITCH + g16 * 32 + cperm * 8) = o; } } }
        __syncthreads();
        if (ui_ + 1 < u_hi - u_lo) { AT_LOAD(AT_UNIT(ui_ + 1)); }
        const int kt0 = (nb == 0) ? ((4 - wid) > 0 ? (4 - wid) : 0) : 0;
        int q32 = r32; asm volatile("" : "+v"(q32));
        f32x16 O0, O1, O2;
#pragma unroll
        for (int i = 0; i < 16; ++i) { O0[i] = 0.f; O1[i] = 0.f; O2[i] = 0.f; }
        float mrun = -1e30f;
        const bf16x8 ones = __builtin_bit_cast(bf16x8, (u32x4){0x3f803f80u, 0x3f803f80u, 0x3f803f80u, 0x3f803f80u});
        for (int kt = kt0; kt < 5; ++kt) {
            const int keybase = 32 * (wid + kt);
            const LAS unsigned char* kp = KS + (keybase + r32) * AT_KPITCH + hi * 16;
            f32x16 sc;
#pragma unroll
            for (int i = 0; i < 16; ++i) sc[i] = 0.f;
#pragma unroll
            for (int d0 = 0; d0 < 4; ++d0) { const bf16x8 kf = *(const LAS bf16x8*)(kp + d0 * 32); sc = __builtin_amdgcn_mfma_f32_32x32x16_bf16(kf, qc[d0], sc, 0, 0, 0); }
            if (kt == 0) {
                asm volatile("" ::: "memory");
#pragma unroll
                for (int i = 0; i < 16; ++i) sc[i] = (crow(i, hi) < q32) ? -1e30f : sc[i]; }
            if (kt == 4) {
                asm volatile("" ::: "memory");
#pragma unroll
                for (int i = 0; i < 16; ++i) sc[i] = (crow(i, hi) > q32) ? -1e30f : sc[i]; }
            float mt = max3f(max3f(sc[0], sc[1], sc[2]), sc[3], sc[4]), mt2 = max3f(max3f(sc[5], sc[6], sc[7]), sc[8], sc[9]);
            mt = max3f(mt, sc[10], sc[11]); mt2 = max3f(mt2, sc[12], sc[13]); mt = max3f(mt, sc[14], sc[15]); mt = max3f(mt, mt2, mt2);
            mt = fmaxf(mt, swap32(mt));
            if (__any(mt > mrun + 8.0f)) {
                const float mnew = fmaxf(mrun, mt), alpha = fast_exp2(mrun - mnew); mrun = mnew;
#pragma unroll
                for (int i = 0; i < 16; ++i) { O0[i] *= alpha; O1[i] *= alpha; O2[i] *= alpha; } }
            const f32x2 m2 = (f32x2){mrun, mrun};
#pragma unroll
            for (int i = 0; i < 16; i += 2) { const f32x2 d = (f32x2){sc[i], sc[i + 1]} - m2; const f32x2 e = (f32x2){fast_exp2(d.x), fast_exp2(d.y)}; sc[i] = e.x; sc[i + 1] = e.y; }
#pragma unroll
            for (int s2 = 0; s2 < 2; ++s2) {
                u32x4 pw; pw.x = cvt_pk_bf16(sc[8 * s2 + 0], sc[8 * s2 + 1]); pw.y = cvt_pk_bf16(sc[8 * s2 + 2], sc[8 * s2 + 3]); pw.z = cvt_pk_bf16(sc[8 * s2 + 4], sc[8 * s2 + 5]); pw.w = cvt_pk_bf16(sc[8 * s2 + 6], sc[8 * s2 + 7]);
                const bf16x8 pf = __builtin_bit_cast(bf16x8, pw);
                const int g16 = (keybase >> 4) + s2;
                const bf16x8 v0 = *(const LAS bf16x8*)(VT + r32 * AT_VPITCH + g16 * 32 + hi * 16);
                const bf16x8 v1 = *(const LAS bf16x8*)(VT + (r32 + 32) * AT_VPITCH + g16 * 32 + hi * 16);
                O0 = __builtin_amdgcn_mfma_f32_32x32x16_bf16(v0, pf, O0, 0, 0, 0);
                O1 = __builtin_amdgcn_mfma_f32_32x32x16_bf16(v1, pf, O1, 0, 0, 0);
                O2 = __builtin_amdgcn_mfma_f32_32x32x16_bf16(ones, pf, O2, 0, 0, 0);
            }
        }
        const float lrun = O2[0];
        const float inv = fast_rcp(lrun);
        { LAS unsigned char* ost = F.lds + (AT_KBYTES + AT_VBYTES) + wid * 4096; const int key = r32 & 7;
          u32x4 w;
          w.x = cvt_pk_bf16(O0[0] * inv, O0[1] * inv); w.y = cvt_pk_bf16(O0[2] * inv, O0[3] * inv); w.z = cvt_pk_bf16(O0[4] * inv, O0[5] * inv); w.w = cvt_pk_bf16(O0[6] * inv, O0[7] * inv); *(LAS u32x4*)(ost + r32 * 128 + (((hi * 4 + 0) ^ key) << 4)) = w;
          w.x = cvt_pk_bf16(O0[8] * inv, O0[9] * inv); w.y = cvt_pk_bf16(O0[10] * inv, O0[11] * inv); w.z = cvt_pk_bf16(O0[12] * inv, O0[13] * inv); w.w = cvt_pk_bf16(O0[14] * inv, O0[15] * inv); *(LAS u32x4*)(ost + r32 * 128 + (((hi * 4 + 1) ^ key) << 4)) = w;
          w.x = cvt_pk_bf16(O1[0] * inv, O1[1] * inv); w.y = cvt_pk_bf16(O1[2] * inv, O1[3] * inv); w.z = cvt_pk_bf16(O1[4] * inv, O1[5] * inv); w.w = cvt_pk_bf16(O1[6] * inv, O1[7] * inv); *(LAS u32x4*)(ost + r32 * 128 + (((hi * 4 + 2) ^ key) << 4)) = w;
          w.x = cvt_pk_bf16(O1[8] * inv, O1[9] * inv); w.y = cvt_pk_bf16(O1[10] * inv, O1[11] * inv); w.z = cvt_pk_bf16(O1[12] * inv, O1[13] * inv); w.w = cvt_pk_bf16(O1[14] * inv, O1[15] * inv); *(LAS u32x4*)(ost + r32 * 128 + (((hi * 4 + 3) ^ key) << 4)) = w;
          LDS_WAIT(); asm volatile("" ::: "memory");
          const int c = lane & 7, rsub = lane >> 3;
#pragma unroll
          for (int q = 0; q < 4; ++q) { const int rq = 8 * q + rsub; const u32x4 wv = *(const LAS u32x4*)(ost + rq * 128 + ((c ^ (rq & 7)) << 4));
              const size_t qt = (size_t)d.b * SEQ + d.r + ((size_t)(nb * 256 + 32 * wid + rq) << d.dsh);
              *(u32x4*)(OB + ((size_t)br * NTOK + qt) * AW + h * 64 + c * 8) = wv; }
          LDS_WAIT(); asm volatile("" ::: "memory"); }
        if (hi == 0) LSE[((size_t)br * NTOK + qtok) * NH + h] = mrun + __log2f(lrun);
        __syncthreads();
    }
#undef AT_LOAD
#undef AT_UNIT
}

__device__ __forceinline__ void combine_phase(const Frame& F, const bf16_t* OB, const float* LSE, const bf16_t* BG, const bf16_t* U, const float* convw, bf16_t* CAT) {
    const int gw = F.bx * 8 + F.wave, NGW = F.G * 8, lane = F.lane, ch0 = 8 * lane, head = lane >> 3;
    f32x4 cw[3][2];
#pragma unroll
    for (int j = 0; j < 3; ++j) { cw[j][0] = *(const f32x4*)(convw + j * CW + ch0); cw[j][1] = *(const f32x4*)(convw + j * CW + ch0 + 4); }
    for (int rb = gw; rb < NTOK / 32; rb += NGW) {
        const size_t tok0 = (size_t)rb * 32; const int t0 = (int)(tok0 & (SEQ - 1));
        const u32x4 z = (u32x4){0u, 0u, 0u, 0u};
        u32x4 u1 = (t0 >= 1) ? *(const u32x4*)(U + (tok0 - 1) * CW + ch0) : z, u0 = (t0 >= 2) ? *(const u32x4*)(U + (tok0 - 2) * CW + ch0) : z;
        float nl0, nl1, nl2; u32x4 no0, no1, no2, nu2, nbg;
#define CB_LOAD(tk) do { nl0 = LSE[(0 * (size_t)NTOK + (tk)) * NH + head]; nl1 = LSE[(1 * (size_t)NTOK + (tk)) * NH + head]; nl2 = LSE[(2 * (size_t)NTOK + (tk)) * NH + head]; \
            no0 = *(const u32x4*)(OB + (0 * (size_t)NTOK + (tk)) * AW + ch0); no1 = *(const u32x4*)(OB + (1 * (size_t)NTOK + (tk)) * AW + ch0); no2 = *(const u32x4*)(OB + (2 * (size_t)NTOK + (tk)) * AW + ch0); \
            nu2 = *(const u32x4*)(U + (tk) * CW + ch0); nbg = *(const u32x4*)(BG + (tk) * CW + ch0); } while (0)
        CB_LOAD(tok0);
        for (int rr = 0; rr < 32; ++rr) { const size_t tok = tok0 + rr;
            const float l0 = nl0, l1 = nl1, l2 = nl2; const u32x4 o0 = no0, o1 = no1, o2 = no2, u2 = nu2, bg = nbg;
            if (rr + 1 < 32) { CB_LOAD(tok + 1); }
            const float mx = fmaxf(l0, fmaxf(l1, l2)); float w0 = fast_exp2(l0 - mx), w1 = fast_exp2(l1 - mx), w2 = fast_exp2(l2 - mx); const float inv = 1.0f / (w0 + w1 + w2); w0 *= inv; w1 *= inv; w2 *= inv;
            u32x4 wa;
#pragma unroll
            for (int k = 0; k < 4; ++k) { const float lo = w0 * bf_lo(o0[k]) + w1 * bf_lo(o1[k]) + w2 * bf_lo(o2[k]), hh = w0 * bf_hi(o0[k]) + w1 * bf_hi(o1[k]) + w2 * bf_hi(o2[k]); wa[k] = cvt_pk_bf16(lo, hh); }
            *(u32x4*)(CAT + tok * DM + ch0) = wa;
            u32x4 wb;
#pragma unroll
            for (int k = 0; k < 4; ++k) { const int n = k >> 1, j0 = (k & 1) * 2;
                const float lo = bf_lo(bg[k]) * (cw[0][n][j0] * bf_lo(u0[k]) + cw[1][n][j0] * bf_lo(u1[k]) + cw[2][n][j0] * bf_lo(u2[k]));
                const float hh = bf_hi(bg[k]) * (cw[0][n][j0 + 1] * bf_hi(u0[k]) + cw[1][n][j0 + 1] * bf_hi(u1[k]) + cw[2][n][j0 + 1] * bf_hi(u2[k]));
                wb[k] = cvt_pk_bf16(lo, hh); }
            *(u32x4*)(CAT + tok * DM + AW + ch0) = wb;
            u0 = u1; u1 = u2; }
#undef CB_LOAD
    }
}

__device__ __forceinline__ void s5_precompute(const Frame& F, int item, const float* a_re, const float* a_im, const float* log_step, const float* b_re, const float* b_im,
                                              const float* c_re, const float* c_im, const float* dsk, bf16_t* Bt2, bf16_t* W1t, float* AL) {
    LAS float* L = (LAS float*)F.lds;
    LAS float* POWr = L; LAS float* POWi = L + 2112; LAS float* BBr = L + 4224; LAS float* BBi = BBr + 1024; LAS float* Cr = BBi + 1024; LAS float* Ci = Cr + 1024; LAS float* Kt = Ci + 1024;
    const int tid = F.tid, g = item >> 2, q = item & 3;
    const float dt = expf(log_step[g]);
    for (int idx = tid; idx < 64 * 33; idx += 512) { const int p = idx / 33, tau = idx - p * 33; const float ar = a_re[g * 64 + p] * dt, ai = a_im[g * 64 + p] * dt;
        const float mag = expf(ar * (float)tau); float sn, cs; sincosf(ai * (float)tau, &sn, &cs); POWr[idx] = mag * cs; POWi[idx] = mag * sn; }
    for (int idx = tid; idx < 1024; idx += 512) { const int p = idx >> 4, c = idx & 15; const float are = a_re[g * 64 + p], aim = a_im[g * 64 + p];
        const float mag = expf(are * dt); float sn, cs; sincosf(aim * dt, &sn, &cs); const float abr = mag * cs, abi = mag * sn, den = are * are + aim * aim, nr = abr - 1.0f;
        const float fre = (nr * are + abi * aim) / den, fim = (abi * are - nr * aim) / den; const float br = b_re[(size_t)(g * 64 + p) * 16 + c], bi = b_im[(size_t)(g * 64 + p) * 16 + c];
        BBr[idx] = fre * br - fim * bi; BBi[idx] = fre * bi + fim * br; }
    for (int idx = tid; idx < 1024; idx += 512) { const int cp = idx >> 6, p = idx & 63; Cr[idx] = c_re[(size_t)(g * 16 + cp) * 64 + p]; Ci[idx] = c_im[(size_t)(g * 16 + cp) * 64 + p]; }
    __syncthreads();
    for (int idx = tid; idx < 2048; idx += 512) { const int tau = idx >> 6, cq = (idx >> 4) & 3, cp = 4 * q + cq, c = idx & 15; float sum = 0.f;
        for (int p = 0; p < 64; ++p) { const float pr = POWr[p * 33 + tau], pi = POWi[p * 33 + tau], br = BBr[p * 16 + c], bi = BBi[p * 16 + c];
            sum += Cr[cp * 64 + p] * (pr * br - pi * bi) - Ci[cp * 64 + p] * (pr * bi + pi * br); }
        if (tau == 0 && cp == c) sum += dsk[g * 16 + c];
        Kt[idx] = sum; }
    __syncthreads();
    for (int qq = tid; qq < 128 * 80; qq += 512) { const int rl = qq / 80, cc = qq - rl * 80, t = rl >> 2, cq = rl & 3, cp = 4 * q + cq, row = t * 16 + cp; float v[8];
        if (cc < 64) { const int s = cc >> 1, c0 = (cc & 1) * 8;
#pragma unroll
            for (int j = 0; j < 8; ++j) v[j] = (s <= t) ? Kt[(t - s) * 64 + cq * 16 + c0 + j] : 0.f;
        } else { const int p0 = (cc - 64) * 4;
#pragma unroll
            for (int j = 0; j < 8; ++j) { const int p = p0 + (j >> 1); const float pr = POWr[p * 33 + t + 1], pi = POWi[p * 33 + t + 1], cr = Cr[cp * 64 + p], ci = Ci[cp * 64 + p];
                v[j] = (j & 1) ? -(cr * pi + ci * pr) : (cr * pr - ci * pi); } }
        u32x4 w; w.x = cvt_pk_bf16(v[0], v[1]); w.y = cvt_pk_bf16(v[2], v[3]); w.z = cvt_pk_bf16(v[4], v[5]); w.w = cvt_pk_bf16(v[6], v[7]);
        *(u32x4*)(Bt2 + ((size_t)g * 512 + row) * S5K + cc * 8) = w; }
    for (int qq = tid; qq < 64 * 64; qq += 512) { const int rl = qq >> 6, cc = qq & 63, s = cc >> 1, c0 = (cc & 1) * 8; float v[8];
        int row;
        if (rl < 32) { row = 32 * q + rl; const int p = row >> 1, im = row & 1; const float pr = POWr[p * 33 + 31 - s], pi = POWi[p * 33 + 31 - s];
#pragma unroll
            for (int j = 0; j < 8; ++j) { const float br = BBr[p * 16 + c0 + j], bi = BBi[p * 16 + c0 + j]; v[j] = im ? (pr * bi + pi * br) : (pr * br - pi * bi); }
        } else { row = 128 + 32 * q + (rl - 32);
#pragma unroll
            for (int j = 0; j < 8; ++j) v[j] = 0.f; }
        u32x4 w; w.x = cvt_pk_bf16(v[0], v[1]); w.y = cvt_pk_bf16(v[2], v[3]); w.z = cvt_pk_bf16(v[4], v[5]); w.w = cvt_pk_bf16(v[6], v[7]);
        *(u32x4*)(W1t + ((size_t)g * 256 + row) * 512 + cc * 8) = w; }
    if (q == 0 && tid < 64) { AL[(g * 64 + tid) * 2] = POWr[tid * 33 + 32]; AL[(g * 64 + tid) * 2 + 1] = POWi[tid * 33 + 32]; }
    __syncthreads();
}
__device__ __forceinline__ void s5_scan(const Frame& F, const float* S, const float* AL, bf16_t* HG) {
    const int gw = F.bx * 8 + F.wave, NGW = F.G * 8, p = F.lane;
    for (int item = gw; item < SG * NB; item += NGW) { const int g = item >> 4, b = item & 15;
        const float ar = AL[(g * 64 + p) * 2], ai = AL[(g * 64 + p) * 2 + 1];
        const size_t row0 = (size_t)g * S5ROWS + b * NCHUNK;
        float xr = 0.f, xi = 0.f;
        f32x2 nv[16];
#pragma unroll
        for (int k = 0; k < 16; ++k) nv[k] = *(const f32x2*)(S + (row0 + k) * 128 + 2 * p);
        for (int c0 = 0; c0 < NCHUNK; c0 += 16) { f32x2 sv[16];
#pragma unroll
            for (int k = 0; k < 16; ++k) sv[k] = nv[k];
            if (c0 + 16 < NCHUNK) {
#pragma unroll
                for (int k = 0; k < 16; ++k) nv[k] = *(const f32x2*)(S + (row0 + c0 + 16 + k) * 128 + 2 * p); }
#pragma unroll
            for (int k = 0; k < 16; ++k) { *(unsigned*)(HG + (row0 + c0 + k) * S5K + 512 + 2 * p) = cvt_pk_bf16(xr, xi);
                const float nr = ar * xr - ai * xi + sv[k].x, ni = ar * xi + ai * xr + sv[k].y; xr = nr; xi = ni; } }
    }
}

template <bool Q8> __device__ __forceinline__ void norm_router(const Frame& F, const bf16_t* x, const float* ng, const float* mod_sh, const float* mod_sc, bf16_t* H,
                                            const float* rw, const float* rb, unsigned* gcnt, int* LIST, float* GATEW, float* SAL, float* SHL, const float* SB, int dry) {
    LAS int* lcnt = (LAS int*)F.lds;
    LAS int* lbase = lcnt + 16;
    LAS int* te = lbase + 16;
    LAS int* tp = te + 512;
    LAS float* tg = (LAS float*)(tp + 512);
    LAS float* tsa = tg + 512;
    LAS float* ths = tsa + 256;
    LAS float* tlg = ths + 256;
    const int lane = F.lane, wave = F.wave, tid = F.tid;
    f32x2 rwv[4][4][4];
#pragma unroll
    for (int j = 0; j < 4; ++j)
#pragma unroll
        for (int i = 0; i < 4; ++i) { const int k = 256 * j + 4 * lane + i; const f32x4 a = *(const f32x4*)(rw + (size_t)k * 8), c = *(const f32x4*)(rw + (size_t)k * 8 + 4);
            rwv[j][i][0] = (f32x2){a.x, a.y}; rwv[j][i][1] = (f32x2){a.z, a.w}; rwv[j][i][2] = (f32x2){c.x, c.y}; rwv[j][i][3] = (f32x2){c.z, c.w}; }
    float rbv[8];
#pragma unroll
    for (int e = 0; e < 8; ++e) rbv[e] = rb[e];
    for (int blk = F.bx; blk < NTOK / 256; blk += F.G) {
        if (tid < 16) lcnt[tid] = 0;
        __syncthreads();
        const int b = blk >> 4;
        f32x4 gs[4], sh[4];
#pragma unroll
        for (int j = 0; j < 4; ++j) { const int col = 256 * j + 4 * lane; const f32x4 g4 = *(const f32x4*)(ng + col), s4 = *(const f32x4*)(mod_sc + (size_t)b * 6144 + col);
            gs[j] = g4 * (s4 + 1.0f); sh[j] = *(const f32x4*)(mod_sh + (size_t)b * 6144 + col); }
        f32x4 nx[4];
#pragma unroll
        for (int j = 0; j < 4; ++j) nx[j] = xb_ld4(x + ((size_t)blk * 256 + wave * 32) * DM + 256 * j + 4 * lane);
#pragma unroll 2
        for (int rr = 0; rr < 32; ++rr) { const int lt = wave * 32 + rr; const size_t row = (size_t)blk * 256 + lt;
            f32x4 v[4]; float ss = 0.f;
#pragma unroll
            for (int j = 0; j < 4; ++j) { v[j] = nx[j]; ss += (v[j].x * v[j].x + v[j].y * v[j].y) + (v[j].z * v[j].z + v[j].w * v[j].w); }
            if (rr + 1 < 32) {
#pragma unroll
                for (int j = 0; j < 4; ++j) nx[j] = xb_ld4(x + (row + 1) * DM + 256 * j + 4 * lane); }
            const float rstd = fast_rsq(wave_sum(ss) * (1.0f / DM) + RMS_EPS);
            u32x2* o8 = (u32x2*)(H + row * DM) + lane; float lg[8]; f32x2 lg2[4]; float amax = 0.f, hn2 = 0.f;
#pragma unroll
            for (int e = 0; e < 4; ++e) lg2[e] = (f32x2){0.f, 0.f};
#pragma unroll
            for (int j = 0; j < 4; ++j) { const f32x4 h = v[j] * rstd * gs[j] + sh[j]; v[j] = h;
                if constexpr (!Q8) { u32x2 w; w.x = cvt_pk_bf16(h.x, h.y); w.y = cvt_pk_bf16(h.z, h.w); o8[64 * j] = w; }
                else { amax = amax3(amax3(amax, h.x, h.y), h.z, h.w); hn2 += (h.x * h.x + h.y * h.y) + (h.z * h.z + h.w * h.w); }
#pragma unroll
                for (int e = 0; e < 4; ++e) lg2[e] += rwv[j][0][e] * h.x + rwv[j][1][e] * h.y + rwv[j][2][e] * h.z + rwv[j][3][e] * h.w; }
            if constexpr (Q8) {
                amax = wave_max(amax);
                const float qs = amax > 0.f ? 127.0f * fast_rcp(amax) : 0.f; unsigned* q8 = (unsigned*)((signed char*)H + row * DM) + lane;
#pragma unroll
                for (int j = 0; j < 4; ++j) q8[64 * j] = q8pack(v[j].x, v[j].y, v[j].z, v[j].w, qs);
                hn2 = wave_sum(hn2);
                if (lane == 0) { tsa[lt] = amax * (1.0f / 127.0f); ths[lt] = hn2; } }
#pragma unroll
            for (int e = 0; e < 8; ++e) lg[e] = 0.f;
            {
              float t0 = swap16add(swap32add(lg2[0].x, lg2[0].y), swap32add(lg2[1].x, lg2[1].y)), t1 = swap16add(swap32add(lg2[2].x, lg2[2].y), swap32add(lg2[3].x, lg2[3].y));
              t0 = row_sum(t0); t1 = row_sum(t1);
              if ((lane & 15) == 0) { const int q = lane >> 4, e0 = ((q & 1) << 1) | (q >> 1); tlg[lt * 8 + e0] = t0; tlg[lt * 8 + 4 + e0] = t1; } }
        }
        LDS_WAIT();
        if (lane < 32) { const int lt = wave * 32 + lane; const f32x4 la = *(const LAS f32x4*)(tlg + lt * 8), lb = *(const LAS f32x4*)(tlg + lt * 8 + 4);
            const float mylg[8] = {la.x + rbv[0], la.y + rbv[1], la.z + rbv[2], la.w + rbv[3], lb.x + rbv[4], lb.y + rbv[5], lb.z + rbv[6], lb.w + rbv[7]}; float b1 = mylg[0], b2 = -3.0e38f; int i1 = 0, i2 = 0;
#pragma unroll
            for (int e = 1; e < 8; ++e) { if (mylg[e] > b1) { b2 = b1; i2 = i1; b1 = mylg[e]; i1 = e; } else if (mylg[e] > b2) { b2 = mylg[e]; i2 = e; } }
            const float g1 = 1.0f / (1.0f + __expf(b2 - b1));
            te[lt * 2] = i1; te[lt * 2 + 1] = i2; tg[lt * 2] = g1; tg[lt * 2 + 1] = 1.0f - g1;
            tp[lt * 2] = __hip_atomic_fetch_add(lcnt + i1, 1, __ATOMIC_RELAXED, __HIP_MEMORY_SCOPE_WORKGROUP);
            tp[lt * 2 + 1] = __hip_atomic_fetch_add(lcnt + 8 + i2, 1, __ATOMIC_RELAXED, __HIP_MEMORY_SCOPE_WORKGROUP);
            }
        __syncthreads();
        if (tid < 16) lbase[tid] = dry ? 0 : (int)__hip_atomic_fetch_add(gcnt + tid, (unsigned)lcnt[tid], __ATOMIC_RELAXED, __HIP_MEMORY_SCOPE_AGENT);
        __syncthreads();
        if (tid < 512 && !dry) { const int lt = tid >> 1, s = tid & 1; const int e = te[lt * 2 + s]; const int pos = lbase[s * 8 + e] + tp[lt * 2 + s];
            LIST[(size_t)(s * 8 + e) * NTOK + pos] = blk * 256 + lt; GATEW[(size_t)(s * 8 + e) * NTOK + pos] = tg[lt * 2 + s];
            if constexpr (Q8) {
                const float rg = SB[2 * e] * (127.0f / WQ), ru = SB[2 * e + 1] * (127.0f / WQ);
                const float shl = fmaxf(QH * ths[lt] * rg * ru, 1e-20f) * (1.0f / 127.0f), sg = tsa[lt] * SB[2 * e], su = tsa[lt] * SB[2 * e + 1];
                SHL[(size_t)(s * 8 + e) * NTOK + pos] = shl; WSP<f32x2>(F, WS_REC)[(size_t)(s * 8 + e) * NTOK + pos] = (f32x2){__int_as_float(blk * 256 + lt), tg[lt * 2 + s] * shl}; ((f32x2*)SAL)[(size_t)(s * 8 + e) * NTOK + pos] = (f32x2){-sg * LOG2E, sg * su / shl}; } }
        __syncthreads();
    }
}

__device__ __forceinline__ void mod_phase(const Frame& F, const float* c, const float* mod_w, const float* mod_b, float* MOD, bf16_t* GATEB) {
    LAS float* cond = (LAS float*)F.lds; LAS float* red = cond + 16384;
    const int tid = F.tid;
    for (int idx = tid; idx < 16384; idx += 512) { const int b = idx >> 10, k = idx & 1023; cond[k * 16 + b] = silu_f(c[idx]); }
    __syncthreads();
    const int kq = tid >> 5, col = tid & 31;
    for (int item = F.bx; item < 4 * 192; item += F.G) { const int l = item / 192, col0 = (item - l * 192) * 32;
        float acc[16];
#pragma unroll
        for (int b = 0; b < 16; ++b) acc[b] = 0.f;
        const float* wp = mod_w + ((size_t)l * DM) * 6144 + col0 + col;
#pragma unroll 4
        for (int kk = 0; kk < 64; ++kk) { const int k = kk * 16 + kq; const float w = wp[(size_t)k * 6144];
            const LAS f32x4* cp = (const LAS f32x4*)(cond + k * 16); const f32x4 c0 = cp[0], c1 = cp[1], c2 = cp[2], c3 = cp[3];
            acc[0] += c0.x * w; acc[1] += c0.y * w; acc[2] += c0.z * w; acc[3] += c0.w * w; acc[4] += c1.x * w; acc[5] += c1.y * w; acc[6] += c1.z * w; acc[7] += c1.w * w;
            acc[8] += c2.x * w; acc[9] += c2.y * w; acc[10] += c2.z * w; acc[11] += c2.w * w; acc[12] += c3.x * w; acc[13] += c3.y * w; acc[14] += c3.z * w; acc[15] += c3.w * w; }
#pragma unroll
        for (int b = 0; b < 16; ++b) red[(kq * 16 + b) * 32 + col] = acc[b];
        __syncthreads();
        { const int b = tid >> 5; float s = mod_b[(size_t)l * 6144 + col0 + col];
#pragma unroll
          for (int q = 0; q < 16; ++q) s += red[(q * 16 + b) * 32 + col];
          MOD[((size_t)l * 16 + b) * 6144 + col0 + col] = s;
          if (col0 >= 5 * DM) GATEB[((size_t)l * 16 + b) * 1024 + (col0 - 5 * DM) + col] = (bf16_t)(cvt_pk_bf16(s, s) & 0xffffu); }
        __syncthreads();
    }
}
__device__ __forceinline__ void rope_phase(const Frame& F, const int* positions, float* ROPE) {
    for (int idx = F.bx * 512 + F.tid; idx < NTOK * 8; idx += F.G * 512) { const int tok = idx >> 3, f = idx & 7;
        const float inv = exp2f(-(float)f * 0.125f * 18.931568569324174f);
        const float ang = (float)positions[tok] * inv; float sn, cs; sincosf(ang, &sn, &cs);
        ROPE[(size_t)tok * 16 + f] = cs; ROPE[(size_t)tok * 16 + 8 + f] = sn; }
}
__device__ __forceinline__ void conv_item_i8(const float* W, int K, int N, signed char* Wt, int row_off, LAS float* scr, int item, int lane, float qs, int mode) {
    const int nblk = N / 64, kb = item / nblk, nb = item - kb * nblk, k0 = 64 * kb, n0 = 64 * nb;
    const int kr = lane >> 4, nq = lane & 15;
    f32x4 v[16];
    const float* src = W + (size_t)(k0 + kr) * N + n0 + 4 * nq;
#pragma unroll
    for (int i = 0; i < 16; ++i) v[i] = *(const f32x4*)(src + (size_t)(4 * i) * N);
    int nqd = nq; if (mode == 1 && n0 < 1024) nqd = (nq == 1) ? 2 : ((nq == 2) ? 1 : nq);
#pragma unroll
    for (int i = 0; i < 16; ++i) { const int kk = 4 * i + kr; *(LAS f32x4*)(scr + kk * 64 + ((4 * nqd) ^ ((kk >> 3) << 3))) = v[i]; }
    LDS_WAIT(); asm volatile("" ::: "memory");
    const int c = lane & 3;
#pragma unroll
    for (int j = 0; j < 4; ++j) { const int n = (lane >> 2) + 16 * j;
        const LAS float* s0 = scr + (16 * c) * 64 + (n ^ ((2 * c) << 3)); const LAS float* s1 = scr + (16 * c + 8) * 64 + (n ^ ((2 * c + 1) << 3));
        u32x4 o; o.x = q8pack(s0[0 * 64], s0[1 * 64], s0[2 * 64], s0[3 * 64], qs); o.y = q8pack(s0[4 * 64], s0[5 * 64], s0[6 * 64], s0[7 * 64], qs);
        o.z = q8pack(s1[0 * 64], s1[1 * 64], s1[2 * 64], s1[3 * 64], qs); o.w = q8pack(s1[4 * 64], s1[5 * 64], s1[6 * 64], s1[7 * 64], qs);
        *(u32x4*)(Wt + (size_t)(row_off + n0 + n) * K + k0 + 16 * c) = o; }
    LDS_WAIT(); asm volatile("" ::: "memory");
}
__device__ __forceinline__ int conv_run_i8(const Frame& F, const float* W, signed char* Wt, int K, int N, int row_off, int base, LAS float* scr, float* sb_out, int mode = 0) {
    const int gw = F.bx * 8 + F.wave, NGW = F.G * 8, nitems = (K / 64) * (N / 64);
    float ss = 0.f;
#pragma unroll
    for (int i = 0; i < 16; ++i) { const f32x4 t = *(const f32x4*)(W + (size_t)(i * 64 + F.lane) * 4); ss += (t.x * t.x + t.y * t.y) + (t.z * t.z + t.w * t.w); }
    const float range = WQ * sqrtf(wave_sum(ss) * (1.0f / 4096.0f)) + 1e-30f, qs = 127.0f / range;
    if (gw == 0 && F.lane == 0) *sb_out = range * (1.0f / 127.0f);
    int first = (gw - base) % NGW; if (first < 0) first += NGW;
    for (int it = first; it < nitems; it += NGW) conv_item_i8(W, K, N, Wt, row_off, scr, it, F.lane, qs, mode);
    return base + nitems;
}

__device__ __forceinline__ int conv_run(const Frame& F, const float* W, bf16_t* Wt, int K, int N, int ldt, int row_off, int mode, int base, LAS float* scr) {
    const int gw = F.bx * 8 + F.wave, NGW = F.G * 8, nitems = (K / 64) * (N / 64);
    int first = (gw - base) % NGW; if (first < 0) first += NGW;
    for (int it = first; it < nitems; it += NGW) conv_item(W, K, N, Wt, ldt, row_off, scr, it, F.lane, mode);
    return base + nitems;
}

#ifndef PHASE_MASK
#define PHASE_MASK 0xffffffffu
#endif
constexpr unsigned PH = PHASE_MASK;
#define PHON(k) ((PH >> (k)) & 1u)
#ifndef DUP_MASK
#define DUP_MASK 0u
#endif
#define DUPON(k) (((DUP_MASK) >> (k)) & 1u)
#ifndef I8_ALL
#define I8_ALL 1
#endif
#ifndef DRY17
#define DRY17 0
#endif
struct Args { const void* in[29]; float* out; unsigned char* ws; int pad0, pad1; };

__device__ __forceinline__ void grid_bar(const Frame& F) {
    XcdBarrier b; b.bar = WSP<unsigned>(F, WS_CTL) + CW_BAR; b.x = xb_xcc_id(); b.st = (volatile LAS unsigned*)(F.lds - RING_OFF + MISC_OFF) + 8;
    xcd_barrier(b);
}

__global__ void __launch_bounds__(512, 2) trunk_fwd(Args args) {
    extern __shared__ __attribute__((aligned(16))) unsigned char lds_raw[];
    Frame F; F.lds = (LAS unsigned char*)lds_raw + RING_OFF; F.tid = threadIdx.x; F.lane = F.tid & 63; F.wave = __builtin_amdgcn_readfirstlane(F.tid >> 6); F.G = gridDim.x; F.bx = blockIdx.x;
    const Frame& F0 = F;
    for (int u = F.tid; u < LDSCTL_BYTES / 4; u += 512) ((LAS unsigned*)((LAS unsigned char*)lds_raw + LDSCTL_OFF))[u] = 0u;
    __syncthreads();
    if (F.tid < 31) { const void* p = (F.tid < 29) ? args.in[F.tid] : (F.tid == 29 ? (const void*)args.out : (const void*)args.ws);
        const unsigned long long v = (unsigned long long)p; LAS unsigned* t = (LAS unsigned*)((LAS unsigned char*)lds_raw + PTAB_OFF) + 2 * F.tid; t[0] = (unsigned)v; t[1] = (unsigned)(v >> 32); }
    __syncthreads();
    (void)xcd_barrier_post(WSP<unsigned>(F, WS_CTL) + CW_BAR, (volatile LAS unsigned*)((LAS unsigned char*)lds_raw + MISC_OFF) + 8);
#define GRID_BAR() grid_bar(F)
#if DUP_MASK
#define PHASE(k) if (PHON(k)) for (int rep_ = DUPON(k) ? 0 : 1; rep_ < 2; ++rep_) if (const int dry_ = opaque_i(rep_ == 0 ? 1 : 0); true) if (const Frame F = fresh(F0); true)
#else
#define PHASE(k) if (PHON(k)) if (constexpr int dry_ = 0; true) if (const Frame F = fresh(F0); true)
#endif
    LAS float* scr = (LAS float*)(F.lds + F.wave * 16384);

    PHASE(0) mod_phase(F, PT<const float>(F, P_C), PT<const float>(F, P_MODW), PT<const float>(F, P_MODB), WSP<float>(F, WS_MOD), WSP<bf16_t>(F, WS_GATEB));
    PHASE(0) rope_phase(F, PT<const int>(F, P_POS), WSP<float>(F, WS_ROPE));
    PHASE(1) {
        int base = 0;
        for (int i = 0; i < 2; ++i) {
            base = conv_run_i8(F, PT<const float>(F, P_WIN) + (size_t)i * DM * NWIN, WSP<signed char>(F, WS_WIN) + (size_t)i * NWIN * DM, DM, NWIN, 0, base, scr, WSP<float>(F, WS_SB) + SBF_OFF + 8 + i, 1);
            base = conv_run(F, PT<const float>(F, P_WOUT) + (size_t)i * DM * DM, WSP<bf16_t>(F, WS_WOUT) + (size_t)i * DM * DM, DM, DM, DM, 0, 2, base, scr);
            base = conv_run_i8(F, PT<const float>(F, P_FG) + (size_t)i * DM * DFF, WSP<signed char>(F, WS_WGU) + (size_t)i * 2 * DFF * DM, DM, DFF, 0, base, scr, WSP<float>(F, WS_SB) + SBF_OFF + 3 * i);
            base = conv_run_i8(F, PT<const float>(F, P_FU) + (size_t)i * DM * DFF, WSP<signed char>(F, WS_WGU) + (size_t)i * 2 * DFF * DM, DM, DFF, DFF, base, scr, WSP<float>(F, WS_SB) + SBF_OFF + 3 * i + 1);
            base = conv_run_i8(F, PT<const float>(F, P_FD) + (size_t)i * DFF * DM, WSP<signed char>(F, WS_WDN) + (size_t)i * DM * DFF, DFF, DM, 0, base, scr, WSP<float>(F, WS_SB) + SBF_OFF + 3 * i + 2);
            base = conv_run(F, PT<const float>(F, P_GLUW) + (size_t)i * DM * 2 * DM, WSP<bf16_t>(F, WS_WGLU) + (size_t)i * 2 * DM * DM, DM, 2 * DM, DM, 0, 0, base, scr);
        }
    }
    GRID_BAR();

    for (int li = 0; li < 2; ++li) {
        {
            const int L = 2 * li; const int modoff = L * 16 * 6144;
            PHASE(2) { const float* modL = WSP<const float>(F, WS_MOD) + modoff;
                if (li == 0) norm_plain<2, true>(F, PT<const float>(F, P_X), PT<const float>(F, P_NMIX) + L * DM, modL + 0 * DM, modL + 1 * DM, WSP<bf16_t>(F, WS_H), nullptr, WSP<float>(F, WS_SHT), nullptr);
                else norm_plain<2, false>(F, WSP<const bf16_t>(F, WS_XB), PT<const float>(F, P_NMIX) + L * DM, modL + 0 * DM, modL + 1 * DM, WSP<bf16_t>(F, WS_H), nullptr, WSP<float>(F, WS_SHT), nullptr); }
            GRID_BAR();
            PHASE(3) { SchedWin S{F.G, F.bx}; EpiWin<true> E{F, li};
              pg8::gemm_phase<EpiWin<true>, SchedWin, false, DM / 2, DM / 2, DM / 2, true>(F.lds, WSP<const bf16_t>(F, WS_H), (const bf16_t*)(WSP<const signed char>(F, WS_WIN) + (size_t)li * NWIN * DM), S, E, nullptr); }
            GRID_BAR();
            PHASE(4) { unsigned char* big = WSP<unsigned char>(F, WS_BIG);
                attn_phase(F, (const bf16_t*)(big + BG_Q), (const bf16_t*)(big + BG_K), (const bf16_t*)(big + BG_V), (bf16_t*)(big + BG_OB), (float*)(big + BG_LSE)); }
            GRID_BAR();
            PHASE(5) { unsigned char* big = WSP<unsigned char>(F, WS_BIG);
                combine_phase(F, (const bf16_t*)(big + BG_OB), (const float*)(big + BG_LSE), (const bf16_t*)(big + BG_BG), (const bf16_t*)(big + BG_U), PT<const float>(F, P_CONVW) + (size_t)li * 3 * CW, WSP<bf16_t>(F, WS_H)); }
            GRID_BAR();
            PHASE(6) { SchedPlain<NTOK / 256, DM / 256> S{F.G, F.bx}; EpiRes E{F, li == 0 ? 1 : 0, modoff + 2 * DM, dry_};
              pg8::gemm_phase<EpiRes, SchedPlain<NTOK / 256, DM / 256>, false, DM, DM, DM>(F.lds, WSP<const bf16_t>(F, WS_H), WSP<const bf16_t>(F, WS_WOUT) + (size_t)li * DM * DM, S, E, nullptr); }
            GRID_BAR();
            PHASE(2) { const float* modL = WSP<const float>(F, WS_MOD) + modoff;
                norm_plain<1, false>(F, WSP<const bf16_t>(F, WS_XB), PT<const float>(F, P_NFFN) + L * DM, modL + 3 * DM, modL + 4 * DM, WSP<bf16_t>(F, WS_H), WSP<float>(F, WS_SCT), WSP<float>(F, WS_SHT), WSP<const float>(F, WS_SB) + SBF_OFF + 3 * li); }
            GRID_BAR();
            PHASE(7) { SchedPair<NTOK / 256, DFF / 128, DFF> S{F.G, F.bx}; EpiActI8<DFF, false, true> E{F, 0, li, 0};
              pg8::gemm_phase<EpiActI8<DFF, false, true>, SchedPair<NTOK / 256, DFF / 128, DFF>, false, DM / 2, DM / 2, DM / 2, true>(F.lds, WSP<const bf16_t>(F, WS_H), (const bf16_t*)(WSP<const signed char>(F, WS_WGU) + (size_t)li * 2 * DFF * DM), S, E, nullptr); }
            GRID_BAR();
            PHASE(8) { SchedPlain<NTOK / 256, DM / 256> S{F.G, F.bx}; EpiResI8 E{F, modoff + 5 * DM, li, dry_};
              pg8::gemm_phase<EpiResI8, SchedPlain<NTOK / 256, DM / 256>, false, DFF / 2, DFF / 2, DFF / 2, true>(F.lds, WSP<const bf16_t>(F, WS_BIG + BG_HID), (const bf16_t*)(WSP<const signed char>(F, WS_WDN) + (size_t)li * DM * DFF), S, E, nullptr); }
            GRID_BAR();
        }
        {
            const int L = 2 * li + 1; const int modoff = L * 16 * 6144;
            PHASE(9) for (int it = F.bx; it < 4 * SG; it += F.G)
                s5_precompute(F, it, PT<const float>(F, P_ARE) + (size_t)li * SG * SP, PT<const float>(F, P_AIM) + (size_t)li * SG * SP, PT<const float>(F, P_LSTEP) + (size_t)li * SG,
                              PT<const float>(F, P_BRE) + (size_t)li * SG * SP * SC, PT<const float>(F, P_BIM) + (size_t)li * SG * SP * SC,
                              PT<const float>(F, P_CRE) + (size_t)li * SG * SC * SP, PT<const float>(F, P_CIM) + (size_t)li * SG * SC * SP, PT<const float>(F, P_SD) + (size_t)li * DM,
                              WSP<bf16_t>(F, WS_BIG + BG_BT2), WSP<bf16_t>(F, WS_BIG + BG_W1T), WSP<float>(F, WS_AL));
            PHASE(10) {
                int base = 0;
                for (int e = 0; e < NE; ++e) {
                    if (I8_ALL || li == 1) {
                        base = conv_run_i8(F, PT<const float>(F, P_MG) + ((size_t)li * NE + e) * DM * DFE, WSP<signed char>(F, WS_WMGU) + (size_t)e * 2 * DFE * DM, DM, DFE, 0, base, scr, WSP<float>(F, WS_SB) + 2 * e);
                        base = conv_run_i8(F, PT<const float>(F, P_MU) + ((size_t)li * NE + e) * DM * DFE, WSP<signed char>(F, WS_WMGU) + (size_t)e * 2 * DFE * DM, DM, DFE, DFE, base, scr, WSP<float>(F, WS_SB) + 2 * e + 1);
                    } else {
                    base = conv_run(F, PT<const float>(F, P_MG) + ((size_t)li * NE + e) * DM * DFE, WSP<bf16_t>(F, WS_WMGU) + (size_t)e * 2 * DFE * DM, DM, DFE, DM, 0, 0, base, scr);
                    base = conv_run(F, PT<const float>(F, P_MU) + ((size_t)li * NE + e) * DM * DFE, WSP<bf16_t>(F, WS_WMGU) + (size_t)e * 2 * DFE * DM, DM, DFE, DM, DFE, 0, base, scr); }
                    base = conv_run_i8(F, PT<const float>(F, P_MD) + ((size_t)li * NE + e) * DFE * DM, WSP<signed char>(F, WS_WMDN) + (size_t)e * DM * DFE, DFE, DM, 0, base, scr, WSP<float>(F, WS_SB) + 16 + e);
                }
            }
            PHASE(11) { const float* modL = WSP<const float>(F, WS_MOD) + modoff;
                norm_s5(F, WSP<const bf16_t>(F, WS_XB), PT<const float>(F, P_NMIX) + L * DM, modL + 0 * DM, modL + 1 * DM, WSP<bf16_t>(F, WS_BIG + BG_HG)); }
            GRID_BAR();
            PHASE(12) { SchedS5A S{F.G, F.bx}; EpiS5A E{F};
              pg8::gemm_phase<EpiS5A, SchedS5A, false, S5K, 512, 512>(F.lds, WSP<const bf16_t>(F, WS_BIG + BG_HG), WSP<const bf16_t>(F, WS_BIG + BG_W1T), S, E, nullptr); }
            GRID_BAR();
            PHASE(13) s5_scan(F, WSP<const float>(F, WS_BIG + BG_S), WSP<const float>(F, WS_AL), WSP<bf16_t>(F, WS_BIG + BG_HG));
            GRID_BAR();
            PHASE(14) { SchedS5B S{F.G, F.bx}; EpiS5B E{F};
              pg8::gemm_phase<EpiS5B, SchedS5B, false, S5K, S5K, S5K>(F.lds, WSP<const bf16_t>(F, WS_BIG + BG_HG), WSP<const bf16_t>(F, WS_BIG + BG_BT2), S, E, nullptr); }
            GRID_BAR();
            PHASE(15) { SchedPair<NTOK / 256, DM / 128, DM> S{F.G, F.bx}; EpiGlu E{F, modoff + 2 * DM, li, dry_};
              pg8::gemm_phase<EpiGlu, SchedPair<NTOK / 256, DM / 128, DM>, false, DM, DM, DM>(F.lds, WSP<const bf16_t>(F, WS_H), WSP<const bf16_t>(F, WS_WGLU) + (size_t)li * 2 * DM * DM, S, E, nullptr); }
            GRID_BAR();
            PHASE(16) { const float* modL = WSP<const float>(F, WS_MOD) + modoff;
                if (I8_ALL || li == 1) norm_router<true>(F, WSP<const bf16_t>(F, WS_XB), PT<const float>(F, P_NFFN) + L * DM, modL + 3 * DM, modL + 4 * DM, WSP<bf16_t>(F, WS_H), PT<const float>(F, P_RW) + (size_t)li * DM * NE, PT<const float>(F, P_RB) + (size_t)li * NE,
                            WSP<unsigned>(F, WS_CTL) + CW_MOECNT + li * 16, WSP<int>(F, WS_LIST), WSP<float>(F, WS_GATEW), WSP<float>(F, WS_SCL), WSP<float>(F, WS_SHL), WSP<const float>(F, WS_SB), dry_);
                else norm_router<false>(F, WSP<const bf16_t>(F, WS_XB), PT<const float>(F, P_NFFN) + L * DM, modL + 3 * DM, modL + 4 * DM, WSP<bf16_t>(F, WS_H), PT<const float>(F, P_RW) + (size_t)li * DM * NE, PT<const float>(F, P_RB) + (size_t)li * NE,
                            WSP<unsigned>(F, WS_CTL) + CW_MOECNT + li * 16, WSP<int>(F, WS_LIST), WSP<float>(F, WS_GATEW), WSP<float>(F, WS_SCL), WSP<float>(F, WS_SHL), WSP<const float>(F, WS_SB), dry_); }
            GRID_BAR();
            for (int slot = 0; slot < 2; ++slot) {
                PHASE(17) { const unsigned* gc = WSP<const unsigned>(F, WS_CTL) + CW_MOECNT + li * 16; int cc = F.bx;
                  if (slot == 1) { const int r8 = ((moe_tiles(gc) * (DM / 256)) % F.G) & ~7; cc = (F.bx + F.G - r8) % F.G; }
                  moe_table(F, gc + slot * 8); SchedMoe<DFE / 128, 0> S{F.G, cc, slot * 8 * NTOK}; EpiActI8<DFE, true, true> E{F, DRY17 ? dry_ : 0, li, slot};
                  pg8::gemm_phase<EpiActI8<DFE, true, true>, SchedMoe<DFE / 128, 0>, true, DM / 2, DM / 2, DM / 2, true>(F.lds, WSP<const bf16_t>(F, WS_H), WSP<const bf16_t>(F, WS_WMGU), S, E, WSP<const int>(F, WS_LIST)); }
                GRID_BAR();
                PHASE(18) { moe_table(F, WSP<const unsigned>(F, WS_CTL) + CW_MOECNT + li * 16 + slot * 8);
                  { SchedMoe<DM / 256, 1> S{F.G, F.bx, slot * 8 * NTOK}; EpiMoeDownI8<false> E{F, L, dry_};
                    pg8::gemm_phase<EpiMoeDownI8<false>, SchedMoe<DM / 256, 1>, false, DFE / 2, DFE / 2, DFE / 2, true>(F.lds, (const bf16_t*)(WSP<const signed char>(F, WS_BIG + BG_HID) + (size_t)slot * HID_SLOT), WSP<const bf16_t>(F, WS_WMDN), S, E, nullptr); }
                  { SchedMoe<DM / 256, 2> S{F.G, F.bx, slot * 8 * NTOK}; EpiMoeDownI8<true> E{F, L, dry_};
                    pg8::gemm_phase<EpiMoeDownI8<true>, SchedMoe<DM / 256, 2>, false, DFE / 2, DFE / 2, DFE / 2, true>(F.lds, (const bf16_t*)(WSP<const signed char>(F, WS_BIG + BG_HID) + (size_t)slot * HID_SLOT), WSP<const bf16_t>(F, WS_WMDN), S, E, nullptr); } }
                if (slot == 1) GRID_BAR();
            }
        }
    }
    PHASE(19) norm_final(F, WSP<const bf16_t>(F, WS_XB), PT<float>(F, P_OUT), PT<const float>(F, P_FNG));
}

extern "C" void kernel_launch(void* const* d_in, const int* in_sizes, int n_in, void* d_out, int out_size, void* d_ws, size_t ws_size, hipStream_t stream) {
    static int grid = 0;
    if (grid == 0) {
        if (n_in != 29 || in_sizes[0] != NTOK * DM || out_size != NTOK * DM || ws_size < WS_END) { fprintf(stderr, "kernel_launch: unexpected shapes (n_in %d, in0 %d, out %d, ws %zu < %zu)\n", n_in, n_in > 0 ? in_sizes[0] : -1, out_size, ws_size, (size_t)WS_END); grid = -1; return; }
        int dev = 0, cus = 0, per_cu = 0;
        if (hipGetDevice(&dev) != hipSuccess || hipDeviceGetAttribute(&cus, hipDeviceAttributeMultiprocessorCount, dev) != hipSuccess) { grid = -1; return; }
        if (hipFuncSetAttribute((const void*)trunk_fwd, hipFuncAttributeMaxDynamicSharedMemorySize, LDS_BYTES) != hipSuccess) { fprintf(stderr, "kernel_launch: hipFuncSetAttribute failed\n"); grid = -1; return; }
        if (hipOccupancyMaxActiveBlocksPerMultiprocessor(&per_cu, (const void*)trunk_fwd, 512, LDS_BYTES) != hipSuccess || per_cu < 1) fprintf(stderr, "kernel_launch: occupancy query says %d\n", per_cu);
        (void)hipGetLastError();
        grid = cus;
    }
    if (grid < 0) return;
    if (hipMemsetAsync((char*)d_ws + WS_CTL, 0, CTL_ZERO_BYTES, stream) != hipSuccess) return;
    Args a{};
    for (int i = 0; i < 29; ++i) a.in[i] = d_in[i];
    a.out = (float*)d_out; a.ws = (unsigned char*)d_ws; a.pad0 = 0; a.pad1 = 0;
    hipLaunchKernelGGL(trunk_fwd, dim3(grid), dim3(512), LDS_BYTES, stream, a);
}
```

```cpp
#include <hip/hip_runtime.h>
#include <cstdio>
#include <cstdint>
#include <type_traits>

#define LAS __attribute__((address_space(3)))
#define GAS __attribute__((address_space(1)))
typedef unsigned short bf16_t;
typedef short bf16x8 __attribute__((ext_vector_type(8)));
typedef float f32x4 __attribute__((ext_vector_type(4)));
typedef float f32x2 __attribute__((ext_vector_type(2)));
typedef float f32x16 __attribute__((ext_vector_type(16)));
typedef unsigned u32x4 __attribute__((ext_vector_type(4)));
typedef unsigned u32x2 __attribute__((ext_vector_type(2)));
typedef int i32x4 __attribute__((ext_vector_type(4)));

constexpr int DM = 1024, NB = 16, SEQ = 4096, NTOK = NB * SEQ;
constexpr int NH = 8, HD = 64, AW = 512, CW = 512;
constexpr int DFF = 2816, NE = 8, DFE = 3584;
constexpr int NWIN = 3072;
constexpr int SG = 64, SP = 64, SC = 16, SL = 32;
constexpr int NCHUNK = SEQ / SL;
constexpr int S5ROWS = NB * NCHUNK;
constexpr int S5K = SL * SC + 2 * SP;
constexpr float RMS_EPS = 1e-6f;
constexpr float LOG2E = 1.4426950408889634f;
constexpr float QSCALE = 0.125f * LOG2E;

constexpr size_t MiB = 1u << 20;
constexpr size_t WS_CTL = 0, CTL_ZERO_BYTES = 1 * MiB;
constexpr size_t WS_MOD = 1 * MiB;
constexpr size_t WS_GATEB = WS_MOD + 1536 * 1024;
constexpr size_t WS_ROPE = 3 * MiB;
constexpr size_t WS_LIST = 7 * MiB;
constexpr size_t WS_GATEW = 11 * MiB;
constexpr size_t WS_AL = 15 * MiB;
constexpr size_t WS_SB = WS_AL + 65536;
constexpr size_t WS_SHT = WS_AL + 131072, WS_SCT = WS_AL + 393216;
constexpr int SBF_OFF = 64;
constexpr float QH = 8.0f, WQ = 4.0f;
constexpr size_t WS_SCL = 16 * MiB;
constexpr size_t WS_SHL = 24 * MiB;
constexpr size_t WS_SAT = WS_SHT, WS_SAL = WS_SHL;
constexpr size_t WS_WIN = 28 * MiB;
constexpr size_t WS_WOUT = 40 * MiB;
constexpr size_t WS_WGU = 44 * MiB;
constexpr size_t WS_WDN = 66 * MiB;
constexpr size_t WS_WGLU = 77 * MiB;
constexpr size_t WS_WMGU = 85 * MiB;
constexpr size_t WS_REC = 160 * MiB;
constexpr size_t WS_WMDN = 197 * MiB;
constexpr size_t WS_H = 253 * MiB;
constexpr size_t WS_BIG = 381 * MiB;
constexpr size_t WS_XB = WS_BIG + 520 * MiB;
constexpr size_t WS_END = WS_XB + 128 * MiB;
constexpr size_t BG_Q = 0, BG_K = 64 * MiB, BG_V = 128 * MiB, BG_BG = 192 * MiB, BG_U = 256 * MiB, BG_OB = 320 * MiB  , BG_LSE = 512 * MiB  ;
constexpr size_t HID_SLOT = 232 * MiB;
constexpr size_t BG_HID = 0;
constexpr size_t BG_HG = 0;
constexpr size_t BG_S = 160 * MiB;
constexpr size_t BG_BT2 = 224 * MiB;
constexpr size_t BG_W1T = 264 * MiB;
constexpr int CW_TMO = 0;
constexpr int CW_MOECNT = 64;
constexpr int CW_BAR = 4096;

constexpr int LDSCTL_OFF = 0, LDSCTL_BYTES = 8192, MISC_OFF = LDSCTL_OFF + 320;
constexpr int ROWBUF_OFF = 2048;
constexpr int UTAB_OFF = 6144, UTAB_N = 64;
constexpr int RING_OFF = 8192, RING_BYTES = 131072;
constexpr int LDS_BYTES = 147456;

#define LDS_WAIT() asm volatile("s_waitcnt lgkmcnt(0)" ::: "memory")
#define VM_WAIT() asm volatile("s_waitcnt vmcnt(0)" ::: "memory")
#define RLX_AGENT __ATOMIC_RELAXED, __HIP_MEMORY_SCOPE_AGENT

__device__ __forceinline__ unsigned cvt_pk_bf16(float lo, float hi) { unsigned r; asm volatile("v_cvt_pk_bf16_f32 %0, %1, %2" : "=v"(r) : "v"(lo), "v"(hi)); return r; }
__device__ __forceinline__ float bf_lo(unsigned w) { return __uint_as_float(w << 16); }
__device__ __forceinline__ float bf_hi(unsigned w) { return __uint_as_float(w & 0xffff0000u); }
template <int CTRL> __device__ __forceinline__ float dppf(float v) { return __builtin_bit_cast(float, __builtin_amdgcn_update_dpp(0, __builtin_bit_cast(int, v), CTRL, 0xf, 0xf, false)); }
__device__ __forceinline__ float wave_sum(float v) {
    v += dppf<0xB1>(v); v += dppf<0x4E>(v); v += dppf<0x124>(v); v += dppf<0x128>(v);
    { auto r = __builtin_amdgcn_permlane16_swap(__float_as_uint(v), __float_as_uint(v), false, false); v = __uint_as_float(r[0]) + __uint_as_float(r[1]); }
    { auto r = __builtin_amdgcn_permlane32_swap(__float_as_uint(v), __float_as_uint(v), false, false); v = __uint_as_float(r[0]) + __uint_as_float(r[1]); }
    return v;
}
__device__ __forceinline__ float swap32add(float a, float b) { auto r = __builtin_amdgcn_permlane32_swap(__float_as_uint(a), __float_as_uint(b), false, false); return __uint_as_float(r[0]) + __uint_as_float(r[1]); }
__device__ __forceinline__ float swap16add(float a, float b) { auto r = __builtin_amdgcn_permlane16_swap(__float_as_uint(a), __float_as_uint(b), false, false); return __uint_as_float(r[0]) + __uint_as_float(r[1]); }
__device__ __forceinline__ float row_sum(float v) { v += dppf<0xB1>(v); v += dppf<0x4E>(v); v += dppf<0x124>(v); v += dppf<0x128>(v); return v; }
__device__ __forceinline__ float wave_max(float v) {
    v = fmaxf(v, dppf<0xB1>(v)); v = fmaxf(v, dppf<0x4E>(v)); v = fmaxf(v, dppf<0x124>(v)); v = fmaxf(v, dppf<0x128>(v));
    { auto r = __builtin_amdgcn_permlane16_swap(__float_as_uint(v), __float_as_uint(v), false, false); v = fmaxf(__uint_as_float(r[0]), __uint_as_float(r[1])); }
    { auto r = __builtin_amdgcn_permlane32_swap(__float_as_uint(v), __float_as_uint(v), false, false); v = fmaxf(__uint_as_float(r[0]), __uint_as_float(r[1])); }
    return v;
}
constexpr float Q8N = 256.0f / 32767.0f, Q8H = 128.0f / 32767.0f;
__device__ __forceinline__ unsigned q8hi(float n0, float n1, float n2, float n3) {
    const unsigned a = __builtin_bit_cast(unsigned, __builtin_amdgcn_cvt_pknorm_i16(n0, n1)), b = __builtin_bit_cast(unsigned, __builtin_amdgcn_cvt_pknorm_i16(n2, n3));
    return __builtin_amdgcn_perm(b, a, 0x07050301u);
}
__device__ __forceinline__ unsigned q8pack(float a, float b, float c, float d, float qs) {
    const float qn = qs * Q8N;
    return q8hi(__builtin_fmaf(a, qn, Q8H), __builtin_fmaf(b, qn, Q8H), __builtin_fmaf(c, qn, Q8H), __builtin_fmaf(d, qn, Q8H));
}
__device__ __forceinline__ f32x4 xb_ld4(const bf16_t* p) { const u32x2 w = *(const u32x2*)p; return (f32x4){bf_lo(w.x), bf_hi(w.x), bf_lo(w.y), bf_hi(w.y)}; }
__device__ __forceinline__ void xb_st4(bf16_t* p, const f32x4 v) { u32x2 w; w.x = cvt_pk_bf16(v.x, v.y); w.y = cvt_pk_bf16(v.z, v.w); *(u32x2*)p = w; }
__device__ __forceinline__ float fast_exp2(float x) { return __builtin_amdgcn_exp2f(x); }
__device__ __forceinline__ float fast_rcp(float x) { return __builtin_amdgcn_rcpf(x); }
__device__ __forceinline__ float fast_rsq(float x) { return __builtin_amdgcn_rsqf(x); }
__device__ __forceinline__ float amax3(float m, float a, float b) { float r; asm("v_max3_f32 %0, %1, |%2|, |%3|" : "=v"(r) : "v"(m), "v"(a), "v"(b)); return r; }
__device__ __forceinline__ float sigmoid_f(float x) { return fast_rcp(1.0f + fast_exp2(-x * LOG2E)); }
__device__ __forceinline__ float silu_f(float x) { return x * sigmoid_f(x); }
__device__ __forceinline__ float gelu_tanh_f(float x) {
    const float u = 0.7978845608028654f * (x + 0.044715f * x * x * x);
    return x * sigmoid_f(2.0f * u);
}

__device__ __forceinline__ f32x2 gelu_tanh_2(f32x2 x) {
    constexpr float A = -2.0f * 0.7978845608028654f * LOG2E, B = A * 0.044715f;
    const f32x2 t = x * ((x * x) * (f32x2){B, B} + (f32x2){A, A});
    const f32x2 d = (f32x2){fast_exp2(t.x), fast_exp2(t.y)} + (f32x2){1.0f, 1.0f};
    return x * (f32x2){fast_rcp(d.x), fast_rcp(d.y)};
}

constexpr int PTAB_OFF = LDSCTL_OFF + 512;
enum { P_X = 0, P_C, P_POS, P_MODW, P_MODB, P_NMIX, P_NFFN, P_WIN, P_CONVW, P_WOUT, P_FG, P_FU, P_FD, P_ARE, P_AIM, P_LSTEP, P_BRE, P_BIM, P_CRE, P_CIM, P_SD, P_GLUW, P_GLUB,
       P_RW, P_RB, P_MG, P_MU, P_MD, P_FNG, P_OUT, P_WS };
struct Frame { LAS unsigned char* lds; int tid, lane, wave, G, bx; };
__device__ __forceinline__ Frame fresh(const Frame& F0) { Frame F; F.lds = F0.lds; int t = threadIdx.x; asm volatile("" : "+v"(t)); F.tid = t; F.lane = t & 63; F.wave = __builtin_amdgcn_readfirstlane(t >> 6);
    int g = gridDim.x, b = blockIdx.x; asm volatile("" : "+s"(g), "+s"(b)); F.G = g; F.bx = b; return F; }
__device__ __forceinline__ int opaque_i(int v) { asm volatile("" : "+s"(v)); return v; }
template <class T> __device__ __forceinline__ T* PT(const Frame& F, int i) {
    unsigned z = 0; asm volatile("" : "+v"(z));
    volatile LAS unsigned* t = (volatile LAS unsigned*)(LAS unsigned char*)(uintptr_t)(z + PTAB_OFF) + 2 * i;
    const unsigned lo = __builtin_amdgcn_readfirstlane(t[0]), hi = __builtin_amdgcn_readfirstlane(t[1]);
    return (T*)(GAS T*)(((unsigned long long)hi << 32) | lo);
}
template <class T> __device__ __forceinline__ T* WSP(const Frame& F, size_t off) { return (T*)(GAS T*)(GAS unsigned char*)(PT<unsigned char>(F, P_WS) + off); }

#define XB_TMO      128
#define XB_XCNT(j)  (256  + 64 * (j))
#define XB_XSUB(j)  (1280 + 64 * (j))
#define XB_XGEN(j)  (2304 + 64 * (j))
#define XB_TOP      3328
#define XB_TOPGEN   3392
#define XCD_BAR_WORDS 3456
#define XB_SPIN_CAP (1u << 22)

__device__ __forceinline__ unsigned xb_ld(unsigned* p)              { return __hip_atomic_load(p, __ATOMIC_RELAXED, __HIP_MEMORY_SCOPE_AGENT); }
__device__ __forceinline__ unsigned xb_add(unsigned* p, unsigned v) { return __hip_atomic_fetch_add(p, v, __ATOMIC_RELAXED, __HIP_MEMORY_SCOPE_AGENT); }
__device__ __forceinline__ unsigned xb_xcc_id() { return (unsigned)__builtin_amdgcn_s_getreg((3 << 11) | 20) & 0xFu; }
#define XB_SPIN(cond, bar) do { unsigned _sp = 0; while (cond) { __builtin_amdgcn_s_sleep(1); \
    if ((++_sp & 255u) == 0u) { if (xb_ld(&(bar)[XB_TMO])) break; if (_sp > XB_SPIN_CAP) { atomicAdd(&(bar)[XB_TMO], 1u); break; } } } } while (0)

struct XcdBarrier { unsigned* bar; unsigned x; volatile LAS unsigned* st; };

__device__ __forceinline__ XcdBarrier xcd_barrier_post(unsigned* bar, volatile LAS unsigned* st) {
    XcdBarrier b; b.bar = bar; b.x = xb_xcc_id(); b.st = st;
    if (threadIdx.x == 0) (void)xb_add(&bar[XB_XCNT(b.x)], 1u);
    return b;
}
__device__ __forceinline__ void xcd_barrier_complete(unsigned* bar, unsigned x, unsigned& nloc, unsigned& nx) {
    const unsigned G = gridDim.x * gridDim.y * gridDim.z;
    unsigned sum, cnt, mine, sp = 0u;
    for (;;) {
        sum = 0u; cnt = 0u; mine = 0u;
#pragma unroll
        for (unsigned j = 0; j < 16; ++j) { const unsigned c = xb_ld(&bar[XB_XCNT(j)]); sum += c; cnt += (c > 0u) ? 1u : 0u; mine = (j == x) ? c : mine; }
        if (sum == G) break;
        __builtin_amdgcn_s_sleep(1);
        if ((++sp & 255u) == 0u) { if (xb_ld(&bar[XB_TMO])) break; if (sp > XB_SPIN_CAP) { atomicAdd(&bar[XB_TMO], 1u); break; } }
    }
    nloc = mine > 0u ? mine : 1u; nx = cnt > 0u ? cnt : 1u;
}
__device__ __forceinline__ void xcd_barrier(const XcdBarrier& b) {
    asm volatile("s_waitcnt vmcnt(0)" ::: "memory");
    __syncthreads();
    if (threadIdx.x == 0) {
        unsigned* bar = b.bar;
        __builtin_amdgcn_s_waitcnt(0);
        unsigned nloc = b.st[0], nx = b.st[1];
        if (nloc == 0u) { xcd_barrier_complete(bar, b.x, nloc, nx); b.st[0] = nloc; b.st[1] = nx; }
        const unsigned old = xb_add(&bar[XB_XSUB(b.x)], 1u);
        const unsigned gen = old / nloc;
        if (old + 1u == (gen + 1u) * nloc) {
            __builtin_amdgcn_fence(__ATOMIC_RELEASE, "agent");
            asm volatile("s_waitcnt vmcnt(0)" ::: "memory");
            const unsigned og = xb_add(&bar[XB_TOP], 1u);
            const unsigned tg = og / nx;
            if (og + 1u == (tg + 1u) * nx) xb_add(&bar[XB_TOPGEN], 1u);
            else XB_SPIN(xb_ld(&bar[XB_TOPGEN]) == tg, bar);
            __builtin_amdgcn_fence(__ATOMIC_ACQUIRE, "agent");
            xb_add(&bar[XB_XGEN(b.x)], 1u);
            asm volatile("s_waitcnt vmcnt(0)" ::: "memory");
        } else {
            XB_SPIN(xb_ld(&bar[XB_XGEN(b.x)]) == gen, bar);
            __builtin_amdgcn_fence(__ATOMIC_ACQUIRE, "agent");
            asm volatile("s_waitcnt vmcnt(0)" ::: "memory");
        }
    }
    __syncthreads();
}

namespace pg8 {
constexpr int BM = 256, BK = 64, HALF = 128, HTB = HALF * BK * 2, STAGE_BYTES = 8 * HTB, NXCD = 8, WGM = 8;
__host__ __device__ __forceinline__ int lds_byte(int r, int c) { const int st = (r >> 4) * 2 + (c >> 5), rr = r & 15, cc = c & 31, ob = rr * 64 + cc * 2; return st * 1024 + (ob ^ (((ob >> 9) & 1) << 5)); }
__host__ __device__ __forceinline__ void stage_rc(int b, int& R, int& C) { const int st = b / 1024, sb = b % 1024, swz = sb ^ (((sb >> 9) & 1) << 5); R = (st >> 1) * 16 + swz / 64; C = (st & 1) * 32 + (swz % 64) / 2; }
__host__ __device__ __forceinline__ int perm32(int rho) { const int n = rho >> 4, i = rho & 15; return 8 * (i >> 2) + 4 * n + (i & 3); }

struct Unit { int arow, brow0, brow1, orow, pn, aux, nvalid, eid, par; };

__device__ __forceinline__ void tile_order_L(int Lin, int nM, int nN, int& pm, int& pn) {
    asm volatile("" : "+s"(nM), "+s"(nN));
    const int nwg = nM * nN; int wgid = Lin; { const int q = nwg / NXCD, r = nwg % NXCD, xcd = wgid % NXCD, off = wgid / NXCD; wgid = (xcd < r ? xcd * (q + 1) : r * (q + 1) + (xcd - r) * q) + off; }
    const int nig = WGM * nN, gid = wgid / nig, fm = gid * WGM, gsz = (nM - fm) < WGM ? (nM - fm) : WGM;
    pm = fm + ((wgid % nig) % gsz); pn = (wgid % nig) / gsz;
}
__device__ __forceinline__ bool tile_order(int i, int c, int G, int nM, int nN, int& pm, int& pn) {
    asm volatile("" : "+s"(nM), "+s"(nN));
    const int nwg = nM * nN; const long L = (long)i * G + c; if (L >= nwg) return false;
    int wgid = (int)L; { const int q = nwg / NXCD, r = nwg % NXCD, xcd = wgid % NXCD, off = wgid / NXCD; wgid = (xcd < r ? xcd * (q + 1) : r * (q + 1) + (xcd - r) * q) + off; }
    const int nig = WGM * nN, gid = wgid / nig, fm = gid * WGM, gsz = (nM - fm) < WGM ? (nM - fm) : WGM;
    pm = fm + ((wgid % nig) % gsz); pn = (wgid % nig) / gsz; return true;
}

template <class Sched> __device__ __forceinline__ bool utab_next(const Sched& S, int i, Unit& u) {
    if (i >= UTAB_N) return false;
    unsigned z = 0; asm volatile("" : "+v"(z));
    volatile LAS u32x4* e = (volatile LAS u32x4*)(LAS unsigned char*)(uintptr_t)(z + UTAB_OFF + i * 32);
    const u32x4 q0 = e[0], q1 = e[1];
    const int a = __builtin_amdgcn_readfirstlane((int)q0.x); if (a < 0) return false;
    u.arow = a; u.brow0 = __builtin_amdgcn_readfirstlane((int)q0.y); u.brow1 = __builtin_amdgcn_readfirstlane((int)q0.z); u.orow = __builtin_amdgcn_readfirstlane((int)q0.w); u.pn = __builtin_amdgcn_readfirstlane((int)q1.x);
    u.aux = __builtin_amdgcn_readfirstlane((int)q1.y); u.nvalid = __builtin_amdgcn_readfirstlane((int)q1.z); u.eid = __builtin_amdgcn_readfirstlane((int)q1.w); u.par = 0; return true;
}
template <class T> __device__ __forceinline__ void zero16(T& t0, T& t1, T& t2, T& t3, bf16x8 z) {
    f32x16 r; asm volatile("v_mfma_f32_32x32x16_bf16 %0, %1, %1, 0" : "=v"(r) : "v"(z));
    t0 = __builtin_bit_cast(T, (f32x4){r[0], r[1], r[2], r[3]}); t1 = __builtin_bit_cast(T, (f32x4){r[4], r[5], r[6], r[7]});
    t2 = __builtin_bit_cast(T, (f32x4){r[8], r[9], r[10], r[11]}); t3 = __builtin_bit_cast(T, (f32x4){r[12], r[13], r[14], r[15]});
}
__device__ __forceinline__ bf16x8 zero_frag() { u32x4 z; asm volatile("v_mov_b32 %0, 0\n\tv_mov_b32 %1, 0\n\tv_mov_b32 %2, 0\n\tv_mov_b32 %3, 0" : "=v"(z.x), "=v"(z.y), "=v"(z.z), "=v"(z.w)); return __builtin_bit_cast(bf16x8, z); }
template <bool I8> __device__ __forceinline__ f32x4 mma1(bf16x8 b, bf16x8 a, f32x4 c) { return __builtin_amdgcn_mfma_f32_16x16x32_bf16(b, a, c, 0, 0, 0); }
template <bool I8> __device__ __forceinline__ i32x4 mma1(bf16x8 b, bf16x8 a, i32x4 c) { return __builtin_amdgcn_mfma_i32_16x16x64_i8(__builtin_bit_cast(i32x4, b), __builtin_bit_cast(i32x4, a), c, 0, 0, 0); }
template <class Epi, class Sched, bool GATHER, int LDA, int LDB, int KDIM, bool I8 = false>
__device__ __forceinline__ void gemm_phase(LAS unsigned char* lds, const bf16_t* Ag, const bf16_t* Btg, const Sched& S, const Epi& E, const int* gather) {
    int tid = threadIdx.x; asm volatile("" : "+v"(tid));
    const int wid = __builtin_amdgcn_readfirstlane(tid >> 6), lane = tid & 63, wr = wid >> 2, wc = wid & 3, fr = lane & 15, fq = lane >> 4;
    constexpr int nt = KDIM / BK;
#ifndef PREF_BACK
#define PREF_BACK 6
#endif
    constexpr int PREF_T = (nt - PREF_BACK) > 0 ? (nt - PREF_BACK) : 0;
    static_assert(KDIM % 128 == 0 && nt >= 8, "K");
    unsigned voffA[2], voffB[2], cofs[2]; int Rr[2];
#pragma unroll
    for (int i = 0; i < 2; ++i) { int R, C; stage_rc(tid * 16 + i * 8192, R, C); const int Rb = Epi::PERM ? ((R & ~31) + perm32(R & 31)) : R;
        Rr[i] = R; cofs[i] = (unsigned)C * 2u; voffA[i] = (unsigned)(R * LDA + C) * 2u; voffB[i] = (unsigned)(Rb * LDB + C) * 2u; }
    constexpr size_t kstep = (size_t)(BK * 2);
    constexpr size_t hstepA = (size_t)HALF * LDA * 2;
    constexpr size_t rowA = (size_t)LDA * 2, rowB = (size_t)LDB * 2;
    const unsigned ldsw = (unsigned)wid * 1024u;
    const int aoff = lds_byte(wr * 64 + fr, fq * 8), boff = lds_byte(wc * 32 + fr, fq * 8);
#define PG8_SA(b, h) (((b) * 2 + (h)) * HTB)
#define PG8_SB(b, h) ((4 + (b) * 2 + (h)) * HTB)
#define PG8_STAGE(bufoff, gbase, voff) do { _Pragma("unroll") for (int _i = 0; _i < 2; ++_i) \
        __builtin_amdgcn_global_load_lds((const unsigned*)((const char*)(gbase) + (voff)[_i]), (LAS unsigned*)(lds + (bufoff) + ldsw + _i * 8192), 16, 0, 0); } while (0)
#define PG8_LDA(dst, b, h) do { _Pragma("unroll") for (int m = 0; m < 4; ++m) _Pragma("unroll") for (int k = 0; k < 2; ++k) dst[m][k] = *(const LAS bf16x8*)(lds + PG8_SA(b, h) + aoff + m * 2048 + k * 1024); } while (0)
#define PG8_LDB(dst, b, h) do { _Pragma("unroll") for (int n = 0; n < 2; ++n) _Pragma("unroll") for (int k = 0; k < 2; ++k) dst[n][k] = *(const LAS bf16x8*)(lds + PG8_SB(b, h) + boff + n * 2048 + k * 1024); } while (0)
#define PG8_MMA(ai, bj, At, Bt) do { __builtin_amdgcn_s_setprio(1); _Pragma("unroll") for (int m = 0; m < 4; ++m) _Pragma("unroll") for (int n = 0; n < 2; ++n) _Pragma("unroll") for (int k = 0; k < 2; ++k) \
        acc[ai][bj][m][n] = mma1<I8>(Bt[n][k], At[m][k], acc[ai][bj][m][n]); __builtin_amdgcn_s_setprio(0); } while (0)
#define PG8_WAIT_V(n) asm volatile("s_waitcnt vmcnt(" #n ")" ::: "memory")
#define PG8_WAIT_L(n) asm volatile("s_waitcnt lgkmcnt(" #n ")" ::: "memory")
#define PG8_BAR __builtin_amdgcn_s_barrier()
#define PG8_SCHED __builtin_amdgcn_sched_barrier(0)
#define PG8_STG_A(buf, h, isnext, koff) do { if constexpr (GATHER) { unsigned _v[2] = { (unsigned)((isnext) ? vN[h][0] : vA[h][0]) * (unsigned)rowA + cofs[0], (unsigned)((isnext) ? vN[h][1] : vA[h][1]) * (unsigned)rowA + cofs[1] }; PG8_STAGE(PG8_SA(buf, h), (const char*)Ag + (koff), _v); } \
        else { PG8_STAGE(PG8_SA(buf, h), ((isnext) ? nA : cA) + (size_t)(h) * hstepA + (koff), voffA); } } while (0)
#define PG8_STG_B(buf, h, isnext, koff) PG8_STAGE(PG8_SB(buf, h), ((isnext) ? ((h) ? nB1 : nB0) : ((h) ? cB1 : cB0)) + (koff), voffB)
#define PG8_GLOAD(dst, u) do { _Pragma("unroll") for (int _h = 0; _h < 2; ++_h) _Pragma("unroll") for (int _i = 0; _i < 2; ++_i) \
        { int _r = _h * HALF + Rr[_i]; _r = _r < (u).nvalid ? _r : (u).nvalid - 1; dst[_h][_i] = gather[(u).arow + _r]; } } while (0)
#define PG8_GUSE(v) asm volatile("" :: "v"(v[0][0]), "v"(v[0][1]), "v"(v[1][0]), "v"(v[1][1]))
#define PG8_GLOAD_ASM(dst, u) do { _Pragma("unroll") for (int _h = 0; _h < 2; ++_h) _Pragma("unroll") for (int _i = 0; _i < 2; ++_i) \
        { int _r = _h * HALF + Rr[_i]; _r = _r < (u).nvalid ? _r : (u).nvalid - 1; const int* _p = gather + ((u).arow + _r); asm volatile("global_load_dword %0, %1, off" : "=v"(dst[_h][_i]) : "v"(_p) : "memory"); } } while (0)
#define PG8_ROWPF(src_, par_) do { if constexpr (Epi::ROWPF) { if (wid < 2) { const char* _rs = (const char*)(src_) + wid * 1024 + lane * 16; \
        __builtin_amdgcn_global_load_lds((const unsigned*)_rs, (LAS unsigned*)(lds - RING_OFF + ROWBUF_OFF + ((par_) & 1) * 2048 + wid * 1024), 16, 0, 0); } } } while (0)
    { LAS int* ut = (LAS int*)(lds - RING_OFF + UTAB_OFF);
      if (tid < UTAB_N) { Unit tu; const bool ok = S.next(tid, tu); LAS int* e = ut + tid * 8;
          e[0] = ok ? tu.arow : -1; e[1] = tu.brow0; e[2] = tu.brow1; e[3] = tu.orow; e[4] = tu.pn; e[5] = tu.aux; e[6] = tu.nvalid; e[7] = tu.eid; }
      __syncthreads(); }
#define PG8_NEXT(i_, u_) pg8::utab_next(S, (i_), (u_))
    int ui = 0; bool has_next = false;
    const char *cA, *cB0, *cB1, *nA, *nB0, *nB1;
    int vA[2][2] = {{0, 0}, {0, 0}}, vN[2][2] = {{0, 0}, {0, 0}};
    const char* rsN = nullptr;
    Unit uC, uN;
    { Unit cur; if (!PG8_NEXT(0, cur)) return;
      cA = (const char*)Ag + (size_t)cur.arow * rowA; cB0 = (const char*)Btg + (size_t)cur.brow0 * rowB; cB1 = (const char*)Btg + (size_t)cur.brow1 * rowB;
      nA = cA; nB0 = cB0; nB1 = cB1;
      Unit n1; has_next = PG8_NEXT(1, n1);
      if (has_next) { nA = (const char*)Ag + (size_t)n1.arow * rowA; nB0 = (const char*)Btg + (size_t)n1.brow0 * rowB; nB1 = (const char*)Btg + (size_t)n1.brow1 * rowB; }
      if constexpr (GATHER) { PG8_GLOAD(vA, cur); if (has_next) { PG8_GLOAD(vN, n1); } else { PG8_GLOAD(vN, cur); } PG8_GUSE(vA); PG8_GUSE(vN); }
      if constexpr (Epi::ROWPF) { PG8_ROWPF(E.row_src(cur), 0); rsN = (const char*)E.row_src(has_next ? n1 : cur); }
      uC = cur; uN = has_next ? n1 : cur; }
    typedef typename std::conditional<I8, i32x4, f32x4>::type acc_t;
    acc_t acc[2][2][4][2];
    { const bf16x8 zf = zero_frag();
#pragma unroll
    for (int a = 0; a < 2; ++a)
#pragma unroll
        for (int b = 0; b < 2; ++b)
#pragma unroll
            for (int m = 0; m < 4; m += 2) zero16(acc[a][b][m][0], acc[a][b][m][1], acc[a][b][m + 1][0], acc[a][b][m + 1][1], zf); }
    bf16x8 At[4][2], B0[2][2], B1[2][2];
    PG8_STG_B(0, 0, false, 0); PG8_STG_B(0, 1, false, 0); PG8_STG_A(0, 0, false, 0); PG8_STG_A(0, 1, false, 0);
    PG8_STG_B(1, 0, false, kstep); PG8_STG_A(1, 0, false, kstep); PG8_STG_B(1, 1, false, kstep);
    if (wr == 1) PG8_BAR;
    PG8_WAIT_V(6); PG8_BAR;
    PG8_BAR;
    for (;;) {
        for (int t = 0; t < nt; t += 2) {
            const bool last = (t == nt - 2);
            const size_t k1 = (size_t)(t + 1) * kstep, k2 = last ? 0 : (size_t)(t + 2) * kstep, k3 = k2 + kstep;
            PG8_LDB(B0, 0, 0); PG8_LDB(B1, 0, 1); PG8_SCHED; PG8_LDA(At, 0, 0); PG8_STG_A(1, 1, false, k1);
            PG8_WAIT_V(8); PG8_WAIT_L(0); PG8_BAR; PG8_MMA(0, 0, At, B0); PG8_MMA(0, 1, At, B1); PG8_BAR; PG8_SCHED;
            PG8_LDA(At, 0, 1); PG8_STG_B(0, 0, last, k2); PG8_STG_B(0, 1, last, k2); PG8_STG_A(0, 0, last, k2);
            PG8_WAIT_V(8); PG8_WAIT_L(0); PG8_BAR; PG8_MMA(1, 0, At, B0); PG8_MMA(1, 1, At, B1); PG8_BAR; PG8_SCHED;
            PG8_LDB(B0, 1, 0); PG8_LDB(B1, 1, 1); PG8_SCHED; PG8_LDA(At, 1, 0); PG8_STG_A(0, 1, last, k2);
            PG8_WAIT_V(8); PG8_WAIT_L(0); PG8_BAR; PG8_MMA(0, 0, At, B0); PG8_MMA(0, 1, At, B1); PG8_BAR; PG8_SCHED;
            PG8_LDA(At, 1, 1); PG8_STG_B(1, 0, last, k3); PG8_STG_B(1, 1, last, k3); PG8_STG_A(1, 0, last, k3);
            PG8_WAIT_V(8); PG8_WAIT_L(0); PG8_BAR; PG8_MMA(1, 0, At, B0); PG8_MMA(1, 1, At, B1); PG8_BAR; PG8_SCHED;
        }
        if (wr == 0) PG8_BAR;
        { Unit cur = uC; cur.par = ui & 1; E(acc, cur, wr, wc, fr, fq); }
        if (!has_next) break;
        { const bf16x8 zf = zero_frag();
#pragma unroll
        for (int a = 0; a < 2; ++a)
#pragma unroll
            for (int b = 0; b < 2; ++b)
#pragma unroll
                for (int m = 0; m < 4; m += 2) zero16(acc[a][b][m][0], acc[a][b][m][1], acc[a][b][m + 1][0], acc[a][b][m + 1][1], zf); }
        cA = nA; cB0 = nB0; cB1 = nB1; ++ui; uC = uN;
        PG8_ROWPF(rsN, ui);
        { Unit n1; has_next = PG8_NEXT(ui + 1, n1);
          if (has_next) { nA = (const char*)Ag + (size_t)n1.arow * rowA; nB0 = (const char*)Btg + (size_t)n1.brow0 * rowB; nB1 = (const char*)Btg + (size_t)n1.brow1 * rowB; if constexpr (Epi::ROWPF) rsN = (const char*)E.row_src(n1); uN = n1; }
          if constexpr (GATHER) {
#pragma unroll
            for (int _h = 0; _h < 2; ++_h) { vA[_h][0] = vN[_h][0]; vA[_h][1] = vN[_h][1]; }
            asm volatile("" : "+v"(vA[0][0]), "+v"(vA[0][1]), "+v"(vA[1][0]), "+v"(vA[1][1]));
            if (has_next) { PG8_GLOAD_ASM(vN, n1); } } }
        if (wr == 1) PG8_BAR;
    }
    PG8_WAIT_V(0);
    PG8_BAR;
#undef PG8_NEXT
#undef PG8_SA
#undef PG8_SB
#undef PG8_STAGE
#undef PG8_LDA
#undef PG8_LDB
#undef PG8_MMA
#undef PG8_WAIT_V
#undef PG8_WAIT_L
#undef PG8_BAR
#undef PG8_SCHED
#undef PG8_STG_A
#undef PG8_STG_B
#undef PG8_GLOAD
#undef PG8_GUSE
#undef PG8_ROWPF
#undef PG8_GLOAD_ASM
}
}

using pg8::Unit;
template <int NM, int NN> struct SchedPlain {
    int G, c;
    __device__ __forceinline__ bool next(int i, Unit& u) const { int pm, pn; if (!pg8::tile_order(i, c, G, NM, NN, pm, pn)) return false;
        u.arow = pm * 256; u.orow = pm * 256; u.brow0 = pn * 256; u.brow1 = pn * 256 + 128; u.pn = pn; u.aux = 0; u.nvalid = 256; return true; }
};
template <int NM, int NN, int OFF1> struct SchedPair {
    int G, c;
    __device__ __forceinline__ bool next(int i, Unit& u) const { int pm, pn; if (!pg8::tile_order(i, c, G, NM, NN, pm, pn)) return false;
        u.arow = pm * 256; u.orow = pm * 256; u.brow0 = pn * 128; u.brow1 = OFF1 + pn * 128; u.pn = pn; u.aux = 0; u.nvalid = 256; return true; }
};
struct SchedWin {
    int G, c;
    __device__ __forceinline__ bool next(int i, Unit& u) const { int pm, pn; if (!pg8::tile_order(i, c, G, NTOK / 256, 12, pm, pn)) return false;
        u.arow = pm * 256; u.orow = pm * 256; u.pn = pn; u.aux = 0; u.nvalid = 256;
        if (pn < 8) { u.brow0 = pn * 256; u.brow1 = pn * 256 + 128; } else { u.brow0 = 2048 + (pn - 8) * 128; u.brow1 = 2560 + (pn - 8) * 128; }
        return true; }
};
struct SchedS5A {
    int G, c;
    __device__ __forceinline__ bool next(int i, Unit& u) const { int pm, pn; if (!pg8::tile_order(i, c, G, SG * 8, 1, pm, pn)) return false;
        const int g = pm >> 3; u.arow = pm * 256; u.orow = pm * 256; u.brow0 = g * 256; u.brow1 = g * 256 + 128; u.pn = 0; u.aux = g; u.nvalid = 256; return true; }
};
struct SchedS5B {
    int G, c;
    __device__ __forceinline__ bool next(int i, Unit& u) const { int pm, pn; if (!pg8::tile_order(i, c, G, SG * 8, 2, pm, pn)) return false;
        const int g = pm >> 3; u.arow = pm * 256; u.orow = (pm & 7) * 256; u.brow0 = g * 512 + pn * 256; u.brow1 = u.brow0 + 128; u.pn = pn; u.aux = g; u.nvalid = 256; return true; }
};
constexpr int MOETAB_OFF = LDSCTL_OFF + 768;
__device__ __forceinline__ void moe_table(const Frame& F, const unsigned* gcnt) {
    if (F.tid < 8) ((LAS int*)(F.lds - RING_OFF + MOETAB_OFF))[F.tid] = (int)__hip_atomic_load(gcnt + F.tid, __ATOMIC_RELAXED, __HIP_MEMORY_SCOPE_AGENT);
    __syncthreads();
}
__device__ __forceinline__ int moe_tiles(const unsigned* gcnt) {
    int n = 0;
#pragma unroll
    for (int e = 0; e < 8; ++e) n += ((int)__builtin_amdgcn_readfirstlane((int)__hip_atomic_load(gcnt + e, __ATOMIC_RELAXED, __HIP_MEMORY_SCOPE_AGENT)) + 255) >> 8;
    return n;
}
template <int NN, int MODE> struct SchedMoe {
    int G, c, lbase  ;
    __device__ __forceinline__ bool next(int i, Unit& u) const {
        int cnt[8], nM = 0;
        unsigned z = 0; asm volatile("" : "+v"(z));
        volatile LAS int* tab = (volatile LAS int*)(LAS unsigned char*)(uintptr_t)(z + MOETAB_OFF);
#pragma unroll
        for (int e = 0; e < 8; ++e) { cnt[e] = __builtin_amdgcn_readfirstlane(tab[e]); nM += (cnt[e] + 255) >> 8; }
        int pm, pn, half = 0;
        if (MODE == 0) { if (!pg8::tile_order(i, c, G, nM, NN, pm, pn)) return false; }
        else { const int nwg = nM * NN, fullU = (nwg / G) * G; const int L = i * G + c;
            if (MODE == 1) { if (L >= fullU) return false; pg8::tile_order_L(L, nM, NN, pm, pn); }
            else { if (L >= 2 * (nwg - fullU)) return false; pg8::tile_order_L(fullU + (L >> 1), nM, NN, pm, pn); half = L & 1; } }
        int e = 0, mt = pm, ce = cnt[0];
#pragma unroll
        for (int k = 0; k < 7; ++k) { const int te = (cnt[k] + 255) >> 8; if (e == k && mt >= te) { mt -= te; e = k + 1; ce = cnt[k + 1]; } }
        const int nv = ce - mt * 256; u.nvalid = nv < 256 ? nv : 256; u.aux = lbase + e * NTOK + mt * 256; u.pn = pn; u.orow = pm * 256; u.eid = e;
        if (MODE == 0) { u.arow = u.aux; u.brow0 = e * (2 * DFE) + pn * 128; u.brow1 = u.brow0 + DFE; }
        else if (MODE == 1) { u.arow = pm * 256; u.brow0 = e * DM + pn * 256; u.brow1 = u.brow0 + 128; }
        else { u.arow = pm * 256; u.brow0 = e * DM + pn * 256 + half * 128; u.brow1 = u.brow0; u.pn = pn * 2 + half; }
        return true; }
};

#define EPI_ARGS const f32x4 (&acc)[2][2][4][2], const Unit& u, int wr, int wc, int fr, int fq
template <bool I8> struct EpiWin {
    static constexpr bool PERM = true, ROWPF = false;
    Frame F; int li;
    typedef typename std::conditional<I8, i32x4, f32x4>::type acc_t;
    static __device__ __forceinline__ f32x4 cv(const f32x4 a, float) { return a; }
    static __device__ __forceinline__ f32x4 cv(const i32x4 a, float s) { return (f32x4){(float)a[0], (float)a[1], (float)a[2], (float)a[3]} * s; }
    __device__ __forceinline__ void operator()(const acc_t (&acc)[2][2][4][2], const Unit& u, int wr, int wc, int fr, int fq) const {
        const int pn = u.pn, row0 = u.orow + wr * 64 + fr;
        unsigned char* big = WSP<unsigned char>(F, WS_BIG);
        const float* sat = WSP<const float>(F, WS_SHT); const float sbw = I8 ? WSP<const float>(F, WS_SB)[SBF_OFF + 8 + li] : 1.0f;
#define EW_RS(ai) float rsv[4]; _Pragma("unroll") for (int m = 0; m < 4; ++m) rsv[m] = I8 ? sat[row0 + (ai) * 128 + m * 16] * sbw : 1.0f
        if (pn < 8) {
            bf16_t* base = (bf16_t*)(big + (size_t)(pn >> 1) * (64 * MiB));
            const float* rope = WSP<float>(F, WS_ROPE);
            const int colt = (pn & 1) * 256 + wc * 32 + 8 * fq;
            const bool dorope = (pn < 4) && ((wc & 1) == 0) && (fq < 2);
            const float sc = pn < 2 ? QSCALE : 1.0f;
#pragma unroll
            for (int ai = 0; ai < 2; ++ai) {
                EW_RS(ai);
                f32x4 csv[4], snv[4];
#pragma unroll
                for (int m = 0; m < 4; ++m) { const int row = row0 + ai * 128 + m * 16; csv[m] = (f32x4){1.f, 1.f, 1.f, 1.f}; snv[m] = (f32x4){0.f, 0.f, 0.f, 0.f};
                    if (dorope) { csv[m] = *(const f32x4*)(rope + (size_t)row * 16 + 4 * fq); snv[m] = *(const f32x4*)(rope + (size_t)row * 16 + 8 + 4 * fq); } }
#pragma unroll
                for (int m = 0; m < 4; ++m) { const int row = row0 + ai * 128 + m * 16;
                    const f32x4 cs = csv[m], sn = snv[m];
#pragma unroll
                    for (int bj = 0; bj < 2; ++bj) { const f32x4 a0 = cv(acc[ai][bj][m][0], rsv[m]), a1 = cv(acc[ai][bj][m][1], rsv[m]);
                        const f32x4 v0 = (a0 * cs - a1 * sn) * sc, v1 = (a1 * cs + a0 * sn) * sc;
                        u32x4 w; w.x = cvt_pk_bf16(v0[0], v0[1]); w.y = cvt_pk_bf16(v0[2], v0[3]); w.z = cvt_pk_bf16(v1[0], v1[1]); w.w = cvt_pk_bf16(v1[2], v1[3]);
                        *(u32x4*)(base + (size_t)row * 512 + colt + bj * 128) = w; } } }
        } else {
            bf16_t* U = (bf16_t*)(big + BG_U);
            const int ch0 = (pn - 8) * 128 + wc * 32 + 8 * fq;
#pragma unroll
            for (int ai = 0; ai < 2; ++ai) { EW_RS(ai);
#pragma unroll
                for (int m = 0; m < 4; ++m) { const int row = row0 + ai * 128 + m * 16;
                    const float rs = rsv[m]; const f32x4 v0 = cv(acc[ai][0][m][0], rs) * cv(acc[ai][1][m][0], rs), v1 = cv(acc[ai][0][m][1], rs) * cv(acc[ai][1][m][1], rs);
                    u32x4 w; w.x = cvt_pk_bf16(v0[0], v0[1]); w.y = cvt_pk_bf16(v0[2], v0[3]); w.z = cvt_pk_bf16(v1[0], v1[1]); w.w = cvt_pk_bf16(v1[2], v1[3]);
                    *(u32x4*)(U + (size_t)row * 512 + ch0) = w; } }
        }
#undef EW_RS
    }
};
struct EpiRes {
    static constexpr bool PERM = true, ROWPF = false;
    Frame F; int base_is_x, gate_off, dry;
    __device__ __forceinline__ void operator()(EPI_ARGS) const {
        const int row0 = u.orow + wr * 64 + fr, col0 = u.pn * 256 + wc * 32 + 8 * fq, b = u.orow >> 12;
        bf16_t* out = WSP<bf16_t>(F, WS_XB); const float* xin = PT<const float>(F, P_X); const float* gate = WSP<const float>(F, WS_MOD) + gate_off;
#pragma unroll
        for (int bj = 0; bj < 2; ++bj) {
            const f32x4 g0 = *(const f32x4*)(gate + (size_t)b * 6144 + col0 + bj * 128), g1 = *(const f32x4*)(gate + (size_t)b * 6144 + col0 + bj * 128 + 4);
#pragma unroll
            for (int ai = 0; ai < 2; ++ai) {
                f32x4 bs[4][2];
#pragma unroll
                for (int m = 0; m < 4; ++m) { const size_t off = (size_t)(row0 + ai * 128 + m * 16) * DM + col0 + bj * 128;
                    if (base_is_x) { bs[m][0] = *(const f32x4*)(xin + off); bs[m][1] = *(const f32x4*)(xin + off + 4); }
                    else { const u32x4 w = *(const u32x4*)(out + off); bs[m][0] = (f32x4){bf_lo(w.x), bf_hi(w.x), bf_lo(w.y), bf_hi(w.y)}; bs[m][1] = (f32x4){bf_lo(w.z), bf_hi(w.z), bf_lo(w.w), bf_hi(w.w)}; } }
#pragma unroll
                for (int m = 0; m < 4; ++m) { const size_t off = (size_t)(row0 + ai * 128 + m * 16) * DM + col0 + bj * 128;
                    const f32x4 v0 = bs[m][0] + g0 * acc[ai][bj][m][0], v1 = bs[m][1] + g1 * acc[ai][bj][m][1];
                    u32x4 o; o.x = cvt_pk_bf16(v0.x, v0.y); o.y = cvt_pk_bf16(v0.z, v0.w); o.z = cvt_pk_bf16(v1.x, v1.y); o.w = cvt_pk_bf16(v1.z, v1.w);
                    if (!dry) *(u32x4*)(out + off) = o; }
                asm volatile("" ::: "memory"); } }
    }
};
struct EpiResI8 {
    static constexpr bool PERM = true, ROWPF = false;
    Frame F; int gate_off, li, dry;
    __device__ __forceinline__ void operator()(const i32x4 (&acc)[2][2][4][2], const Unit& u, int wr, int wc, int fr, int fq) const {
        const int row0 = u.orow + wr * 64 + fr, col0 = u.pn * 256 + wc * 32 + 8 * fq, b = u.orow >> 12;
        bf16_t* out = WSP<bf16_t>(F, WS_XB); const float* gate = WSP<const float>(F, WS_MOD) + gate_off; const float* sht = WSP<const float>(F, WS_SHT); const float sbd = WSP<const float>(F, WS_SB)[SBF_OFF + 3 * li + 2];
        f32x4 gv[2][2];
#pragma unroll
        for (int bj = 0; bj < 2; ++bj)
#pragma unroll
            for (int n = 0; n < 2; ++n) gv[bj][n] = *(const f32x4*)(gate + (size_t)b * 6144 + col0 + bj * 128 + n * 4) * sbd;
        float shv[2][4];
#pragma unroll
        for (int ai = 0; ai < 2; ++ai)
#pragma unroll
            for (int m = 0; m < 4; ++m) shv[ai][m] = sht[row0 + ai * 128 + m * 16];
#pragma unroll
        for (int ai = 0; ai < 2; ++ai) {
            u32x4 bs[4][2];
#pragma unroll
            for (int m = 0; m < 4; ++m)
#pragma unroll
                for (int bj = 0; bj < 2; ++bj) bs[m][bj] = *(const u32x4*)(out + (size_t)(row0 + ai * 128 + m * 16) * DM + col0 + bj * 128);
#pragma unroll
            for (int m = 0; m < 4; ++m) { const float sh = shv[ai][m];
#pragma unroll
                for (int bj = 0; bj < 2; ++bj) { const u32x4 w = bs[m][bj]; u32x4 o;
#pragma unroll
                    for (int n = 0; n < 2; ++n) { const f32x4 b4 = (f32x4){bf_lo(w[2 * n]), bf_hi(w[2 * n]), bf_lo(w[2 * n + 1]), bf_hi(w[2 * n + 1])}; const i32x4 a = acc[ai][bj][m][n]; const f32x4 af = (f32x4){(float)a[0], (float)a[1], (float)a[2], (float)a[3]};
                        const f32x4 v = b4 + (gv[bj][n] * sh) * af; o[2 * n] = cvt_pk_bf16(v.x, v.y); o[2 * n + 1] = cvt_pk_bf16(v.z, v.w); }
                    if (!dry) *(u32x4*)(out + (size_t)(row0 + ai * 128 + m * 16) * DM + col0 + bj * 128) = o; } }
            asm volatile("" ::: "memory"); }
    }
};
template <int LDH> struct EpiAct {
    static constexpr bool PERM = true, ROWPF = false;
    Frame F; int dry;
    __device__ __forceinline__ void operator()(EPI_ARGS) const {
        bf16_t* hid = WSP<bf16_t>(F, WS_BIG + BG_HID);
        const int row0 = u.orow + wr * 64 + fr, ch0 = u.pn * 128 + wc * 32 + 8 * fq;
#pragma unroll
        for (int ai = 0; ai < 2; ++ai)
#pragma unroll
            for (int m = 0; m < 4; ++m) { f32x4 v[2];
#pragma unroll
                for (int n = 0; n < 2; ++n) { const f32x4 gt = acc[ai][0][m][n], up = acc[ai][1][m][n];
#pragma unroll
                    for (int j = 0; j < 4; ++j) v[n][j] = silu_f(gt[j]) * up[j]; }
                u32x4 w; w.x = cvt_pk_bf16(v[0][0], v[0][1]); w.y = cvt_pk_bf16(v[0][2], v[0][3]); w.z = cvt_pk_bf16(v[1][0], v[1][1]); w.w = cvt_pk_bf16(v[1][2], v[1][3]);
                if (!dry) *(u32x4*)(hid + (size_t)(row0 + ai * 128 + m * 16) * LDH + ch0) = w; }
    }
};
template <int LDH, bool MOE, bool OUT8> struct EpiActI8 {
    static constexpr bool PERM = true, ROWPF = true;
    Frame F; int dry, li, slot;
    __device__ __forceinline__ const void* row_src(const Unit& u) const { return MOE ? (const void*)(WSP<const f32x2>(F, WS_SCL) + u.aux) : (const void*)(WSP<const f32x2>(F, WS_SCT) + u.orow); }
    __device__ __forceinline__ void operator()(const i32x4 (&acc)[2][2][4][2], const Unit& u, int wr, int wc, int fr, int fq) const {
        signed char* hid = WSP<signed char>(F, WS_BIG + BG_HID) + (size_t)slot * HID_SLOT;
        const LAS f32x2* rowbuf = (const LAS f32x2*)(F.lds - RING_OFF + ROWBUF_OFF + u.par * 2048);
        const int row0 = u.orow + wr * 64 + fr, ch0 = u.pn * 128 + wc * 32 + 8 * fq;
#pragma unroll
        for (int ai = 0; ai < 2; ++ai)
#pragma unroll
            for (int m = 0; m < 4; ++m) { const int r = ai * 128 + wr * 64 + m * 16 + fr; const f32x2 rs = rowbuf[r]; const float sgl = rs.x, cc = OUT8 ? rs.y * Q8N : rs.y, icc = fast_rcp(cc); f32x4 v[2]; const f32x2 q8h2 = (f32x2){Q8H, Q8H};
                const f32x2 sgl2 = (f32x2){sgl, sgl}, icc2 = (f32x2){icc, icc};
#pragma unroll
                for (int n = 0; n < 2; ++n) { const i32x4 gt = acc[ai][0][m][n], up = acc[ai][1][m][n];
#pragma unroll
                    for (int j = 0; j < 4; j += 2) { const f32x2 gi = (f32x2){(float)gt[j], (float)gt[j + 1]}, ui = (f32x2){(float)up[j], (float)up[j + 1]};
                        const f32x2 t = gi * sgl2; const f32x2 d = (f32x2){fast_exp2(t.x), fast_exp2(t.y)} * icc2 + icc2; const f32x2 r = (f32x2){fast_rcp(d.x), fast_rcp(d.y)};
                        const f32x2 o = OUT8 ? (gi * ui) * r + q8h2 : (gi * ui) * r; v[n][j] = o.x; v[n][j + 1] = o.y; } }
                if constexpr (OUT8) { u32x2 w; w.x = q8hi(v[0][0], v[0][1], v[0][2], v[0][3]); w.y = q8hi(v[1][0], v[1][1], v[1][2], v[1][3]);
                    if (!dry) *(u32x2*)(hid + (size_t)(row0 + ai * 128 + m * 16) * LDH + ch0) = w; }
                else { u32x4 w; w.x = cvt_pk_bf16(v[0][0], v[0][1]); w.y = cvt_pk_bf16(v[0][2], v[0][3]); w.z = cvt_pk_bf16(v[1][0], v[1][1]); w.w = cvt_pk_bf16(v[1][2], v[1][3]);
                    if (!dry) *(u32x4*)((bf16_t*)hid + (size_t)(row0 + ai * 128 + m * 16) * LDH + ch0) = w; } }
    }
};
struct EpiS5A {
    static constexpr bool PERM = false, ROWPF = false;
    Frame F;
    __device__ __forceinline__ void operator()(EPI_ARGS) const {
        float* S = WSP<float>(F, WS_BIG + BG_S);
        const int row0 = u.orow + wr * 64 + fr, col0 = wc * 32 + 4 * fq;
#pragma unroll
        for (int ai = 0; ai < 2; ++ai)
#pragma unroll
            for (int m = 0; m < 4; ++m)
#pragma unroll
                for (int n = 0; n < 2; ++n) *(f32x4*)(S + (size_t)(row0 + ai * 128 + m * 16) * 128 + col0 + n * 16) = acc[ai][0][m][n];
    }
};
struct EpiS5B {
    static constexpr bool PERM = true, ROWPF = false;
    Frame F;
    __device__ __forceinline__ void operator()(EPI_ARGS) const {
        bf16_t* gact = WSP<bf16_t>(F, WS_H);
        const int g = u.aux, c0 = 8 * (fq & 1);
        const unsigned colbase = (unsigned)(g * 16 + c0) + (unsigned)(16 * u.pn + 2 * wc + (fq >> 1)) * DM;
#pragma unroll
        for (int ai = 0; ai < 2; ++ai)
#pragma unroll
            for (int m = 0; m < 4; ++m) { const int ridx = u.orow + ai * 128 + wr * 64 + m * 16 + fr; const int b = ridx >> 7, ch = ridx & 127;
                const unsigned tok0 = (unsigned)(b * SEQ + ch * SL);
#pragma unroll
                for (int bj = 0; bj < 2; ++bj) {
                    const f32x4 a0 = acc[ai][bj][m][0], a1 = acc[ai][bj][m][1]; f32x4 v0, v1;
#pragma unroll
                    for (int j = 0; j < 4; j += 2) { const f32x2 g0 = gelu_tanh_2((f32x2){a0[j], a0[j + 1]}), g1 = gelu_tanh_2((f32x2){a1[j], a1[j + 1]}); v0[j] = g0.x; v0[j + 1] = g0.y; v1[j] = g1.x; v1[j + 1] = g1.y; }
                    u32x4 w; w.x = cvt_pk_bf16(v0[0], v0[1]); w.y = cvt_pk_bf16(v0[2], v0[3]); w.z = cvt_pk_bf16(v1[0], v1[1]); w.w = cvt_pk_bf16(v1[2], v1[3]);
                    *(u32x4*)(gact + (size_t)(tok0 * DM + colbase + (unsigned)(8 * bj) * DM)) = w; } }
    }
};
struct EpiGlu {
    static constexpr bool PERM = true, ROWPF = false;
    Frame F; int gate_off, li, dry;
    __device__ __forceinline__ void operator()(EPI_ARGS) const {
        bf16_t* out = WSP<bf16_t>(F, WS_XB); const float* gate = WSP<const float>(F, WS_MOD) + gate_off; const float* bias = PT<const float>(F, P_GLUB) + (size_t)li * 2 * DM;
        const int row0 = u.orow + wr * 64 + fr, ch0 = u.pn * 128 + wc * 32 + 8 * fq, b = u.orow >> 12;
        f32x4 gv[2], bv[2], bg[2];
#pragma unroll
        for (int n = 0; n < 2; ++n) { gv[n] = *(const f32x4*)(gate + (size_t)b * 6144 + ch0 + 4 * n); bv[n] = *(const f32x4*)(bias + ch0 + 4 * n); bg[n] = *(const f32x4*)(bias + DM + ch0 + 4 * n) * (-LOG2E); }
        u32x4 bs[2][4];
#pragma unroll
        for (int ai = 0; ai < 2; ++ai)
#pragma unroll
            for (int m = 0; m < 4; ++m) bs[ai][m] = *(const u32x4*)(out + (size_t)(row0 + ai * 128 + m * 16) * DM + ch0);
#pragma unroll
        for (int ai = 0; ai < 2; ++ai)
#pragma unroll
            for (int m = 0; m < 4; ++m) { const size_t off = (size_t)(row0 + ai * 128 + m * 16) * DM + ch0; const u32x4 w = bs[ai][m]; f32x4 o[2];
#pragma unroll
                for (int n = 0; n < 2; ++n) { const f32x4 va = acc[ai][0][m][n] + bv[n], ga = acc[ai][1][m][n], bl = bg[n]; f32x4 mix;
#pragma unroll
                    for (int j = 0; j < 4; j += 2) { const f32x2 t = (f32x2){ga[j], ga[j + 1]} * (f32x2){-LOG2E, -LOG2E} + (f32x2){bl[j], bl[j + 1]};
                        const f32x2 d = (f32x2){fast_exp2(t.x), fast_exp2(t.y)} + (f32x2){1.0f, 1.0f}; const f32x2 mx = (f32x2){va[j], va[j + 1]} * (f32x2){fast_rcp(d.x), fast_rcp(d.y)}; mix[j] = mx.x; mix[j + 1] = mx.y; }
                    const f32x4 b4 = (f32x4){bf_lo(w[2 * n]), bf_hi(w[2 * n]), bf_lo(w[2 * n + 1]), bf_hi(w[2 * n + 1])}; o[n] = b4 + gv[n] * mix; }
                u32x4 ow; ow.x = cvt_pk_bf16(o[0].x, o[0].y); ow.y = cvt_pk_bf16(o[0].z, o[0].w); ow.z = cvt_pk_bf16(o[1].x, o[1].y); ow.w = cvt_pk_bf16(o[1].z, o[1].w);
                if (!dry) *(u32x4*)(out + off) = ow; }
    }
};
struct EpiMoeDown {
    static constexpr bool PERM = false, ROWPF = false;
    Frame F; int gate_off, dry;
    __device__ __forceinline__ void operator()(EPI_ARGS) const {
        bf16_t* x = WSP<bf16_t>(F, WS_XB); const float* gate = WSP<const float>(F, WS_MOD) + gate_off; const int* list = WSP<const int>(F, WS_LIST); const float* gatew = WSP<const float>(F, WS_GATEW);
        const int col0 = u.pn * 256 + wc * 32 + 4 * fq;
#pragma unroll
        for (int ai = 0; ai < 2; ++ai)
#pragma unroll
            for (int m = 0; m < 4; ++m) { const int r = ai * 128 + wr * 64 + m * 16 + fr;
                if (r < u.nvalid) { const int tok = list[u.aux + r]; const float gw = gatew[u.aux + r]; const int b = tok >> 12; const size_t off = (size_t)tok * DM + col0;
#pragma unroll
                    for (int bj = 0; bj < 2; ++bj)
#pragma unroll
                        for (int n = 0; n < 2; ++n) { const f32x4 gv = *(const f32x4*)(gate + (size_t)b * 6144 + col0 + bj * 128 + n * 16); const f32x4 bs = xb_ld4(x + off + bj * 128 + n * 16);
                            if (!dry) xb_st4(x + off + bj * 128 + n * 16, bs + (gv * gw) * acc[ai][bj][m][n]); } }
                asm volatile("" ::: "memory"); }
    }
};

template <bool HALFU> struct EpiMoeDownI8 {
    static constexpr bool PERM = true, ROWPF = true;
    Frame F; int L, dry;
    __device__ __forceinline__ const void* row_src(const Unit& u) const { return (const void*)(WSP<const f32x2>(F, WS_REC) + u.aux); }
    __device__ __forceinline__ void operator()(const i32x4 (&acc)[2][2][4][2], const Unit& u, int wr, int wc, int fr, int fq) const {
        bf16_t* x = WSP<bf16_t>(F, WS_XB); const bf16_t* gateb = WSP<const bf16_t>(F, WS_GATEB) + (size_t)L * 16 * 1024;
        const float sbd = WSP<const float>(F, WS_SB)[16 + u.eid];
        const LAS f32x2* rowbuf = (const LAS f32x2*)(F.lds - RING_OFF + ROWBUF_OFF + u.par * 2048);
        const int col0 = (HALFU ? u.pn * 128 : u.pn * 256) + wc * 32 + 8 * fq;
        constexpr int NBJ = HALFU ? 1 : 2;
#pragma unroll
        for (int ai = 0; ai < 2; ++ai) {
            int tokv[4]; float cwv[4];
#pragma unroll
            for (int m = 0; m < 4; ++m) { const int r = ai * 128 + wr * 64 + m * 16 + fr; const f32x2 rc = rowbuf[r < u.nvalid ? r : u.nvalid - 1];
                tokv[m] = __float_as_int(rc.x); cwv[m] = rc.y * sbd; }
#pragma unroll
            for (int bj = 0; bj < NBJ; ++bj) {
                u32x4 bs[4], gq[4];
#pragma unroll
                for (int m = 0; m < 4; ++m) { const int tok = tokv[m]; bs[m] = *(const u32x4*)(x + (size_t)tok * DM + col0 + bj * 128); gq[m] = *(const u32x4*)(gateb + (size_t)(tok >> 12) * 1024 + col0 + bj * 128); }
#pragma unroll
                for (int m = 0; m < 4; ++m) { const int r = ai * 128 + wr * 64 + m * 16 + fr; const size_t off = (size_t)tokv[m] * DM + col0 + bj * 128; const float cw = cwv[m];
                    if (r < u.nvalid && !dry) { const u32x4 w = bs[m], g = gq[m]; u32x4 o;
#pragma unroll
                        for (int n = 0; n < 2; ++n) { const f32x4 b4 = (f32x4){bf_lo(w[2 * n]), bf_hi(w[2 * n]), bf_lo(w[2 * n + 1]), bf_hi(w[2 * n + 1])}, g4 = (f32x4){bf_lo(g[2 * n]), bf_hi(g[2 * n]), bf_lo(g[2 * n + 1]), bf_hi(g[2 * n + 1])};
                            const i32x4 a = acc[ai][bj][m][n]; const f32x4 af = (f32x4){(float)a[0], (float)a[1], (float)a[2], (float)a[3]}; const f32x4 v = b4 + (g4 * cw) * af;
                            o[2 * n] = cvt_pk_bf16(v.x, v.y); o[2 * n + 1] = cvt_pk_bf16(v.z, v.w); }
                        *(u32x4*)(x + off) = o; } }
                asm volatile("" ::: "memory"); } }
    }
};

__device__ __forceinline__ void conv_item(const float* W, int K, int N, bf16_t* Wt, int ldt, int row_off, LAS float* scr, int item, int lane, int mode) {
    const int nblk = N / 64, kb = item / nblk, nb = item - kb * nblk, k0 = 64 * kb, n0 = 64 * nb;
    const int kr = lane >> 4, nq = lane & 15;
    int nqd = nq;
    if (mode == 1 && n0 < 1024) nqd = (nq == 1) ? 2 : ((nq == 2) ? 1 : nq);
    f32x4 v[16];
    const float* src = W + (size_t)(k0 + kr) * N + n0 + 4 * nq;
#pragma unroll
    for (int i = 0; i < 16; ++i) v[i] = *(const f32x4*)(src + (size_t)(4 * i) * N);
#pragma unroll
    for (int i = 0; i < 16; ++i) { const int kk = 4 * i + kr; int kd = kk;
        if (mode == 2 && k0 < 512) { const int blk = kk >> 5, d5 = kk & 31; kd = ((d5 >> 2) & 1) * 32 + blk * 16 + (d5 & 3) + 4 * (d5 >> 3); }
        *(LAS f32x4*)(scr + kd * 64 + ((4 * nqd) ^ ((kd >> 3) << 3))) = v[i]; }
    LDS_WAIT(); asm volatile("" ::: "memory");
    const int c = lane & 7;
#pragma unroll
    for (int j = 0; j < 8; ++j) { const int n = (lane >> 3) + 8 * j; const LAS float* sp = scr + (8 * c) * 64 + (n ^ (c << 3));
        u32x4 o; o.x = cvt_pk_bf16(sp[0 * 64], sp[1 * 64]); o.y = cvt_pk_bf16(sp[2 * 64], sp[3 * 64]); o.z = cvt_pk_bf16(sp[4 * 64], sp[5 * 64]); o.w = cvt_pk_bf16(sp[6 * 64], sp[7 * 64]);
        *(u32x4*)(Wt + (size_t)(row_off + n0 + n) * ldt + k0 + 8 * c) = o; }
    LDS_WAIT(); asm volatile("" ::: "memory");
}

template <int Q8, bool XF32> __device__ __forceinline__ void norm_plain(const Frame& F, const void* xv, const float* ng, const float* mod_sh, const float* mod_sc, bf16_t* H, float* SAT, float* SHT, const float* sbf) {
    const int gw = F.bx * 8 + F.wave, NGW = F.G * 8;
    for (int rb = gw; rb < NTOK / 32; rb += NGW) {
        const int b = rb >> 7;
        f32x4 gs[4], sh[4];
#pragma unroll
        for (int j = 0; j < 4; ++j) { const int col = 256 * j + 4 * F.lane; const f32x4 g4 = *(const f32x4*)(ng + col), s4 = *(const f32x4*)(mod_sc + (size_t)b * 6144 + col);
            gs[j] = g4 * (s4 + 1.0f); sh[j] = *(const f32x4*)(mod_sh + (size_t)b * 6144 + col); }
        const float* x = (const float*)xv; const bf16_t* xb = (const bf16_t*)xv;
        f32x4 nx[2][4];
        { const size_t e0 = (size_t)rb * 32 * DM + 4 * F.lane;
#pragma unroll
          for (int q = 0; q < 2; ++q)
#pragma unroll
              for (int j = 0; j < 4; ++j) nx[q][j] = XF32 ? *(const f32x4*)(x + e0 + q * DM + 256 * j) : xb_ld4(xb + e0 + q * DM + 256 * j); }
#pragma unroll 2
        for (int rr = 0; rr < 32; rr += 2) { const size_t row = (size_t)rb * 32 + rr;
            f32x4 v[2][4]; float ss[2] = {0.f, 0.f};
#pragma unroll
            for (int q = 0; q < 2; ++q)
#pragma unroll
                for (int j = 0; j < 4; ++j) v[q][j] = nx[q][j];
            if (rr + 2 < 32) { const size_t e0 = (row + 2) * DM + 4 * F.lane;
#pragma unroll
                for (int q = 0; q < 2; ++q)
#pragma unroll
                    for (int j = 0; j < 4; ++j) nx[q][j] = XF32 ? *(const f32x4*)(x + e0 + q * DM + 256 * j) : xb_ld4(xb + e0 + q * DM + 256 * j); }
#pragma unroll
            for (int q = 0; q < 2; ++q)
#pragma unroll
                for (int j = 0; j < 4; ++j) ss[q] += (v[q][j].x * v[q][j].x + v[q][j].y * v[q][j].y) + (v[q][j].z * v[q][j].z + v[q][j].w * v[q][j].w);
#pragma unroll
            for (int q = 0; q < 2; ++q) { const float rstd = fast_rsq(wave_sum(ss[q]) * (1.0f / DM) + RMS_EPS);
                if constexpr (!Q8) { u32x2* o8 = (u32x2*)(H + (row + q) * DM) + F.lane;
#pragma unroll
                    for (int j = 0; j < 4; ++j) { const f32x4 h = v[q][j] * rstd * gs[j] + sh[j]; u32x2 w; w.x = cvt_pk_bf16(h.x, h.y); w.y = cvt_pk_bf16(h.z, h.w); o8[64 * j] = w; }
                } else { float amax = 0.f, hn2 = 0.f;
#pragma unroll
                    for (int j = 0; j < 4; ++j) { const f32x4 h = v[q][j] * rstd * gs[j] + sh[j]; v[q][j] = h; amax = amax3(amax3(amax, h.x, h.y), h.z, h.w); hn2 += (h.x * h.x + h.y * h.y) + (h.z * h.z + h.w * h.w); }
                    amax = wave_max(amax);
                    hn2 = wave_sum(hn2);
                    const float qs = amax > 0.f ? 127.0f * fast_rcp(amax) : 0.f; unsigned* q8 = (unsigned*)((signed char*)H + (row + q) * DM) + F.lane;
#pragma unroll
                    for (int j = 0; j < 4; ++j) q8[64 * j] = q8pack(v[q][j].x, v[q][j].y, v[q][j].z, v[q][j].w, qs);
                    if constexpr (Q8 == 2) { if (F.lane == 0) SHT[row + q] = amax * (1.0f / 127.0f); }
                    else if (F.lane == 0) { const float sa_ = amax * (1.0f / 127.0f), sht_ = fmaxf(QH * hn2 * (sbf[0] * (127.0f / WQ)) * (sbf[1] * (127.0f / WQ)), 1e-20f) * (1.0f / 127.0f), sg = sa_ * sbf[0], su = sa_ * sbf[1];
                        SHT[row + q] = sht_; ((f32x2*)SAT)[row + q] = (f32x2){-sg * LOG2E, sg * su / sht_}; } } } }
    }
}
__device__ __forceinline__ void norm_s5(const Frame& F, const bf16_t* x, const float* ng, const float* mod_sh, const float* mod_sc, bf16_t* HG) {
    const int gw = F.bx * 8 + F.wave, NGW = F.G * 8, lane = F.lane;
    LAS unsigned char* scr = F.lds + F.wave * 16384;
    for (int rb = gw; rb < NTOK / 32; rb += NGW) {
        const int b = rb >> 7, chunk = rb & 127;
        f32x4 gs[4], sh[4];
#pragma unroll
        for (int j = 0; j < 4; ++j) { const int col = 16 * lane + 4 * j; const f32x4 g4 = *(const f32x4*)(ng + col), s4 = *(const f32x4*)(mod_sc + (size_t)b * 6144 + col);
            gs[j] = g4 * (s4 + 1.0f); sh[j] = *(const f32x4*)(mod_sh + (size_t)b * 6144 + col); }
        u32x4 nx[2][2];
#pragma unroll
        for (int q = 0; q < 2; ++q)
#pragma unroll
            for (int j = 0; j < 2; ++j) nx[q][j] = *(const u32x4*)(x + ((size_t)rb * 32 + q) * DM + 16 * lane + 8 * j);
        for (int r8 = 0; r8 < 4; ++r8) {
#pragma unroll 2
            for (int jt = 0; jt < 8; ++jt) { const int rr = r8 * 8 + jt; const size_t row = (size_t)rb * 32 + rr;
                f32x4 v[4]; float ss = 0.f;
                { const u32x4 a = nx[0][0], c = nx[0][1]; nx[0][0] = nx[1][0]; nx[0][1] = nx[1][1];
                  v[0] = (f32x4){bf_lo(a.x), bf_hi(a.x), bf_lo(a.y), bf_hi(a.y)}; v[1] = (f32x4){bf_lo(a.z), bf_hi(a.z), bf_lo(a.w), bf_hi(a.w)};
                  v[2] = (f32x4){bf_lo(c.x), bf_hi(c.x), bf_lo(c.y), bf_hi(c.y)}; v[3] = (f32x4){bf_lo(c.z), bf_hi(c.z), bf_lo(c.w), bf_hi(c.w)}; }
#pragma unroll
                for (int j = 0; j < 4; ++j) ss += (v[j].x * v[j].x + v[j].y * v[j].y) + (v[j].z * v[j].z + v[j].w * v[j].w);
                if (rr + 2 < 32) {
#pragma unroll
                    for (int j = 0; j < 2; ++j) nx[1][j] = *(const u32x4*)(x + (row + 2) * DM + 16 * lane + 8 * j); }
                const float rstd = fast_rsq(wave_sum(ss) * (1.0f / DM) + RMS_EPS);
                u32x4 w0, w1; f32x4 h;
                h = v[0] * rstd * gs[0] + sh[0]; w0.x = cvt_pk_bf16(h.x, h.y); w0.y = cvt_pk_bf16(h.z, h.w);
                h = v[1] * rstd * gs[1] + sh[1]; w0.z = cvt_pk_bf16(h.x, h.y); w0.w = cvt_pk_bf16(h.z, h.w);
                h = v[2] * rstd * gs[2] + sh[2]; w1.x = cvt_pk_bf16(h.x, h.y); w1.y = cvt_pk_bf16(h.z, h.w);
                h = v[3] * rstd * gs[3] + sh[3]; w1.z = cvt_pk_bf16(h.x, h.y); w1.w = cvt_pk_bf16(h.z, h.w);
                const int key = lane & 15;
                *(LAS u32x4*)(scr + lane * 256 + (((2 * jt) ^ key) << 4)) = w0; *(LAS u32x4*)(scr + lane * 256 + (((2 * jt + 1) ^ key) << 4)) = w1; }
            LDS_WAIT(); asm volatile("" ::: "memory");
            { const int c = lane & 15, rsub = lane >> 4;
#pragma unroll
              for (int q = 0; q < 16; ++q) { const int g = 4 * q + rsub; const u32x4 wv = *(const LAS u32x4*)(scr + g * 256 + ((c ^ (g & 15)) << 4));
                  *(u32x4*)(HG + ((size_t)g * S5ROWS + b * NCHUNK + chunk) * S5K + r8 * 128 + c * 8) = wv; } }
            LDS_WAIT(); asm volatile("" ::: "memory");
        }
    }
}
__device__ __forceinline__ void norm_final(const Frame& F, const bf16_t* x, float* out, const float* ng) {
    const int gw = F.bx * 8 + F.wave, NGW = F.G * 8;
    f32x4 gs[4];
#pragma unroll
    for (int j = 0; j < 4; ++j) gs[j] = *(const f32x4*)(ng + 256 * j + 4 * F.lane);
    f32x4 nx[2][4];
#pragma unroll
    for (int q = 0; q < 2; ++q)
#pragma unroll
        for (int j = 0; j < 4; ++j) nx[q][j] = xb_ld4(x + ((size_t)gw + (size_t)q * NGW) * DM + 256 * j + 4 * F.lane);
    for (size_t row = gw; row < (size_t)NTOK; row += NGW) {
        f32x4* xr = (f32x4*)(out + row * DM) + F.lane; f32x4 v[4]; float ss = 0.f;
#pragma unroll
        for (int j = 0; j < 4; ++j) { v[j] = nx[0][j]; nx[0][j] = nx[1][j]; ss += (v[j].x * v[j].x + v[j].y * v[j].y) + (v[j].z * v[j].z + v[j].w * v[j].w); }
        if (row + 2 * (size_t)NGW < (size_t)NTOK) {
#pragma unroll
            for (int j = 0; j < 4; ++j) nx[1][j] = xb_ld4(x + (row + 2 * (size_t)NGW) * DM + 256 * j + 4 * F.lane); }
        const float rstd = fast_rsq(wave_sum(ss) * (1.0f / DM) + RMS_EPS);
#pragma unroll
        for (int j = 0; j < 4; ++j) xr[64 * j] = v[j] * rstd * gs[j];
    }
}

constexpr int AT_KPITCH = 144, AT_VPITCH = 784, AT_KBYTES = 384 * AT_KPITCH, AT_VBYTES = 64 * AT_VPITCH;
constexpr int AT_UNITS = NB * NH * 48;
__device__ __forceinline__ int crow(int r, int hi) { return (r & 3) + 8 * (r >> 2) + 4 * hi; }
__device__ __forceinline__ float max3f(float a, float b, float c) { float r; asm("v_max3_f32 %0, %1, %2, %3" : "=v"(r) : "v"(a), "v"(b), "v"(c)); return r; }
__device__ __forceinline__ float swap32(float v) { auto r = __builtin_amdgcn_permlane32_swap(__float_as_uint(v), __float_as_uint(v), false, false); return __uint_as_float(__builtin_amdgcn_mbcnt_hi(~0u, __builtin_amdgcn_mbcnt_lo(~0u, 0u)) < 32 ? r[1] : r[0]); }
struct AttnUnitDesc { int b, h, br, dsh, r, nb; };
__device__ __forceinline__ AttnUnitDesc attn_unit_desc(int un) {
    AttnUnitDesc d; const int bh = un / 48, u48 = un - bh * 48, idx = u48 & 15; d.br = u48 >> 4; d.dsh = 2 * d.br;
    d.r = (d.br == 0) ? 0 : ((d.br == 1) ? (idx & 3) : idx); d.nb = (d.br == 0) ? idx : ((d.br == 1) ? (idx >> 2) : 0); d.b = bh >> 3; d.h = bh & 7; return d;
}
__device__ __forceinline__ void attn_phase(const Frame& F, const bf16_t* Qb, const bf16_t* Kb, const bf16_t* Vb, bf16_t* OB, float* LSE) {
    LAS unsigned char* KS = F.lds; LAS unsigned char* VT = F.lds + AT_KBYTES;
    const int tid = F.tid, lane = F.lane, wid = F.wave, r32 = lane & 31, hi = lane >> 5;
    const int per = (AT_UNITS + F.G - 1) / F.G;
    const int u_lo = F.bx * per, u_hi = (u_lo + per < AT_UNITS) ? u_lo + per : AT_UNITS;
    if (u_lo >= u_hi) return;
    const bool xcdmap = (F.G == 256);
    const int xc = F.bx & 7, rk = F.bx >> 3;
#define AT_UNIT(i_) (xcdmap ? ((xc * 16 + 2 * ((i_) / 3)) * 48 + rk + 32 * ((i_) % 3)) : (u_lo + (i_)))
    u32x4 kreg[6], vreg[2][4];
#define AT_LOAD(un_) do { const AttnUnitDesc d_ = attn_unit_desc(un_); const int jb_ = d_.nb * 256 - 128; const size_t tokb_ = (size_t)d_.b * SEQ; \
        _Pragma("unroll") for (int k = 0; k < 6; ++k) { const int c = tid + 512 * k, row = c >> 3, cc = c & 7, j = jb_ + row; kreg[k] = (u32x4){0u, 0u, 0u, 0u}; \
            if (j >= 0) kreg[k] = *(const u32x4*)(Kb + (tokb_ + d_.r + ((size_t)j << d_.dsh)) * AW + d_.h * 64 + cc * 8); } \
        _Pragma("unroll") for (int it = 0; it < 2; ++it) { const int item = tid + 512 * it, kq = item >> 3, dc = item & 7; \
            _Pragma("unroll") for (int e = 0; e < 4; ++e) { const int j = jb_ + 4 * kq + e; vreg[it][e] = (u32x4){0u, 0u, 0u, 0u}; \
                if (item < 768 && j >= 0) vreg[it][e] = *(const u32x4*)(Vb + (tokb_ + d_.r + ((size_t)j << d_.dsh)) * AW + d_.h * 64 + dc * 8); } } \
        } while (0)
    AT_LOAD(AT_UNIT(0));
    for (int ui_ = 0; ui_ < u_hi - u_lo; ++ui_) { const int un = AT_UNIT(ui_);
        const AttnUnitDesc d = attn_unit_desc(un);
        const int br = d.br, nb = d.nb, h = d.h;
        const size_t qtok = (size_t)d.b * SEQ + d.r + ((size_t)(nb * 256 + 32 * wid + r32) << d.dsh);
        bf16x8 qc[4];
#pragma unroll
        for (int d0 = 0; d0 < 4; ++d0) qc[d0] = *(const bf16x8*)(Qb + qtok * AW + h * 64 + 16 * d0 + 8 * hi);
#pragma unroll
        for (int k = 0; k < 6; ++k) { const int c = tid + 512 * k, row = c >> 3, cc = c & 7; *(LAS u32x4*)(KS + row * AT_KPITCH + cc * 16) = kreg[k]; }
#pragma unroll
        for (int it = 0; it < 2; ++it) { const int item = tid + 512 * it, kq = item >> 3, dc = item & 7;
            if (item < 768) { const int g16 = kq >> 2, cq = kq & 3, cperm = ((cq & 1) << 1) | (cq >> 1);
#pragma unroll
                for (int jj = 0; jj < 8; ++jj) { const int w = jj >> 1; unsigned e0 = vreg[it][0][w], e1 = vreg[it][1][w], e2 = vreg[it][2][w], e3 = vreg[it][3][w];
                    u32x2 o;
                    if (jj & 1) { o.x = (e0 >> 16) | (e1 & 0xffff0000u); o.y = (e2 >> 16) | (e3 & 0xffff0000u); }
                    else { o.x = (e0 & 0xffffu) | (e1 << 16); o.y = (e2 & 0xffffu) | (e3 << 16); }
                    *(LAS u32x2*)(VT + (dc * 8 + jj) * AT_VPITCH + g16 * 32 + cperm * 8) = o; } } }
        __syncthreads();
        if (ui_ + 1 < u_hi - u_lo) { AT_LOAD(AT_UNIT(ui_ + 1)); }
        const int kt0 = (nb == 0) ? ((4 - wid) > 0 ? (4 - wid) : 0) : 0;
        int q32 = r32; asm volatile("" : "+v"(q32));
        f32x16 O0, O1, O2;
#pragma unroll
        for (int i = 0; i < 16; ++i) { O0[i] = 0.f; O1[i] = 0.f; O2[i] = 0.f; }
        float mrun = -1e30f;
        const bf16x8 ones = __builtin_bit_cast(bf16x8, (u32x4){0x3f803f80u, 0x3f803f80u, 0x3f803f80u, 0x3f803f80u});
        for (int kt = kt0; kt < 5; ++kt) {
            const int keybase = 32 * (wid + kt);
            const LAS unsigned char* kp = KS + (keybase + r32) * AT_KPITCH + hi * 16;
            f32x16 sc;
#pragma unroll
            for (int i = 0; i < 16; ++i) sc[i] = 0.f;
#pragma unroll
            for (int d0 = 0; d0 < 4; ++d0) { const bf16x8 kf = *(const LAS bf16x8*)(kp + d0 * 32); sc = __builtin_amdgcn_mfma_f32_32x32x16_bf16(kf, qc[d0], sc, 0, 0, 0); }
            if (kt == 0) {
                asm volatile("" ::: "memory");
#pragma unroll
                for (int i = 0; i < 16; ++i) sc[i] = (crow(i, hi) < q32) ? -1e30f : sc[i]; }
            if (kt == 4) {
                asm volatile("" ::: "memory");
#pragma unroll
                for (int i = 0; i < 16; ++i) sc[i] = (crow(i, hi) > q32) ? -1e30f : sc[i]; }
            float mt = max3f(max3f(sc[0], sc[1], sc[2]), sc[3], sc[4]), mt2 = max3f(max3f(sc[5], sc[6], sc[7]), sc[8], sc[9]);
            mt = max3f(mt, sc[10], sc[11]); mt2 = max3f(mt2, sc[12], sc[13]); mt = max3f(mt, sc[14], sc[15]); mt = max3f(mt, mt2, mt2);
            mt = fmaxf(mt, swap32(mt));
            if (__any(mt > mrun + 8.0f)) {
                const float mnew = fmaxf(mrun, mt), alpha = fast_exp2(mrun - mnew); mrun = mnew;
#pragma unroll
                for (int i = 0; i < 16; ++i) { O0[i] *= alpha; O1[i] *= alpha; O2[i] *= alpha; } }
            const f32x2 m2 = (f32x2){mrun, mrun};
#pragma unroll
            for (int i = 0; i < 16; i += 2) { const f32x2 d = (f32x2){sc[i], sc[i + 1]} - m2; const f32x2 e = (f32x2){fast_exp2(d.x), fast_exp2(d.y)}; sc[i] = e.x; sc[i + 1] = e.y; }
#pragma unroll
            for (int s2 = 0; s2 < 2; ++s2) {
                u32x4 pw; pw.x = cvt_pk_bf16(sc[8 * s2 + 0], sc[8 * s2 + 1]); pw.y = cvt_pk_bf16(sc[8 * s2 + 2], sc[8 * s2 + 3]); pw.z = cvt_pk_bf16(sc[8 * s2 + 4], sc[8 * s2 + 5]); pw.w = cvt_pk_bf16(sc[8 * s2 + 6], sc[8 * s2 + 7]);
                const bf16x8 pf = __builtin_bit_cast(bf16x8, pw);
                const int g16 = (keybase >> 4) + s2;
                const bf16x8 v0 = *(const LAS bf16x8*)(VT + r32 * AT_VPITCH + g16 * 32 + hi * 16);
                const bf16x8 v1 = *(const LAS bf16x8*)(VT + (r32 + 32) * AT_VPITCH + g16 * 32 + hi * 16);
                O0 = __builtin_amdgcn_mfma_f32_32x32x16_bf16(v0, pf, O0, 0, 0, 0);
                O1 = __builtin_amdgcn_mfma_f32_32x32x16_bf16(v1, pf, O1, 0, 0, 0);
                O2 = __builtin_amdgcn_mfma_f32_32x32x16_bf16(ones, pf, O2, 0, 0, 0);
            }
        }
        const float lrun = O2[0];
        const float inv = fast_rcp(lrun);
        { LAS unsigned char* ost = F.lds + (AT_KBYTES + AT_VBYTES) + wid * 4096; const int key = r32 & 7;
          u32x4 w;
          w.x = cvt_pk_bf16(O0[0] * inv, O0[1] * inv); w.y = cvt_pk_bf16(O0[2] * inv, O0[3] * inv); w.z = cvt_pk_bf16(O0[4] * inv, O0[5] * inv); w.w = cvt_pk_bf16(O0[6] * inv, O0[7] * inv); *(LAS u32x4*)(ost + r32 * 128 + (((hi * 4 + 0) ^ key) << 4)) = w;
          w.x = cvt_pk_bf16(O0[8] * inv, O0[9] * inv); w.y = cvt_pk_bf16(O0[10] * inv, O0[11] * inv); w.z = cvt_pk_bf16(O0[12] * inv, O0[13] * inv); w.w = cvt_pk_bf16(O0[14] * inv, O0[15] * inv); *(LAS u32x4*)(ost + r32 * 128 + (((hi * 4 + 1) ^ key) << 4)) = w;
          w.x = cvt_pk_bf16(O1[0] * inv, O1[1] * inv); w.y = cvt_pk_bf16(O1[2] * inv, O1[3] * inv); w.z = cvt_pk_bf16(O1[4] * inv, O1[5] * inv); w.w = cvt_pk_bf16(O1[6] * inv, O1[7] * inv); *(LAS u32x4*)(ost + r32 * 128 + (((hi * 4 + 2) ^ key) << 4)) = w;
          w.x = cvt_pk_bf16(O1[8] * inv, O1[9] * inv); w.y = cvt_pk_bf16(O1[10] * inv, O1[11] * inv); w.z = cvt_pk_bf16(O1[12] * inv, O1[13] * inv); w.w = cvt_pk_bf16(O1[14] * inv, O1[15] * inv); *(LAS u32x4*)(ost + r32 * 128 + (((hi * 4 + 3) ^ key) << 4)) = w;
          LDS_WAIT(); asm volatile("" ::: "memory");
          const int c = lane & 7, rsub = lane >> 3;
#pragma unroll
          for (int q = 0; q < 4; ++q) { const int rq = 8 * q + rsub; const u32x4 wv = *(const LAS u32x4*)(ost + rq * 128 + ((c ^ (rq & 7)) << 4));
              const size_t qt = (size_t)d.b * SEQ + d.r + ((size_t)(nb * 256 + 32 * wid + rq) << d.dsh);
              *(u32x4*)(OB + ((size_t)br * NTOK + qt) * AW + h * 64 + c * 8) = wv; }
          LDS_WAIT(); asm volatile("" ::: "memory"); }
        if (hi == 0) LSE[((size_t)br * NTOK + qtok) * NH + h] = mrun + __log2f(lrun);
        __syncthreads();
    }
#undef AT_LOAD
#undef AT_UNIT
}

__device__ __forceinline__ void combine_phase(const Frame& F, const bf16_t* OB, const float* LSE, const bf16_t* BG, const bf16_t* U, const float* convw, bf16_t* CAT) {
    const int gw = F.bx * 8 + F.wave, NGW = F.G * 8, lane = F.lane, ch0 = 8 * lane, head = lane >> 3;
    f32x4 cw[3][2];
#pragma unroll
    for (int j = 0; j < 3; ++j) { cw[j][0] = *(const f32x4*)(convw + j * CW + ch0); cw[j][1] = *(const f32x4*)(convw + j * CW + ch0 + 4); }
    for (int rb = gw; rb < NTOK / 32; rb += NGW) {
        const size_t tok0 = (size_t)rb * 32; const int t0 = (int)(tok0 & (SEQ - 1));
        const u32x4 z = (u32x4){0u, 0u, 0u, 0u};
        u32x4 u1 = (t0 >= 1) ? *(const u32x4*)(U + (tok0 - 1) * CW + ch0) : z, u0 = (t0 >= 2) ? *(const u32x4*)(U + (tok0 - 2) * CW + ch0) : z;
        float nl0, nl1, nl2; u32x4 no0, no1, no2, nu2, nbg;
#define CB_LOAD(tk) do { nl0 = LSE[(0 * (size_t)NTOK + (tk)) * NH + head]; nl1 = LSE[(1 * (size_t)NTOK + (tk)) * NH + head]; nl2 = LSE[(2 * (size_t)NTOK + (tk)) * NH + head]; \
            no0 = *(const u32x4*)(OB + (0 * (size_t)NTOK + (tk)) * AW + ch0); no1 = *(const u32x4*)(OB + (1 * (size_t)NTOK + (tk)) * AW + ch0); no2 = *(const u32x4*)(OB + (2 * (size_t)NTOK + (tk)) * AW + ch0); \
            nu2 = *(const u32x4*)(U + (tk) * CW + ch0); nbg = *(const u32x4*)(BG + (tk) * CW + ch0); } while (0)
        CB_LOAD(tok0);
        for (int rr = 0; rr < 32; ++rr) { const size_t tok = tok0 + rr;
            const float l0 = nl0, l1 = nl1, l2 = nl2; const u32x4 o0 = no0, o1 = no1, o2 = no2, u2 = nu2, bg = nbg;
            if (rr + 1 < 32) { CB_LOAD(tok + 1); }
            const float mx = fmaxf(l0, fmaxf(l1, l2)); float w0 = fast_exp2(l0 - mx), w1 = fast_exp2(l1 - mx), w2 = fast_exp2(l2 - mx); const float inv = 1.0f / (w0 + w1 + w2); w0 *= inv; w1 *= inv; w2 *= inv;
            u32x4 wa;
#pragma unroll
            for (int k = 0; k < 4; ++k) { const float lo = w0 * bf_lo(o0[k]) + w1 * bf_lo(o1[k]) + w2 * bf_lo(o2[k]), hh = w0 * bf_hi(o0[k]) + w1 * bf_hi(o1[k]) + w2 * bf_hi(o2[k]); wa[k] = cvt_pk_bf16(lo, hh); }
            *(u32x4*)(CAT + tok * DM + ch0) = wa;
            u32x4 wb;
#pragma unroll
            for (int k = 0; k < 4; ++k) { const int n = k >> 1, j0 = (k & 1) * 2;
                const float lo = bf_lo(bg[k]) * (cw[0][n][j0] * bf_lo(u0[k]) + cw[1][n][j0] * bf_lo(u1[k]) + cw[2][n][j0] * bf_lo(u2[k]));
                const float hh = bf_hi(bg[k]) * (cw[0][n][j0 + 1] * bf_hi(u0[k]) + cw[1][n][j0 + 1] * bf_hi(u1[k]) + cw[2][n][j0 + 1] * bf_hi(u2[k]));
                wb[k] = cvt_pk_bf16(lo, hh); }
            *(u32x4*)(CAT + tok * DM + AW + ch0) = wb;
            u0 = u1; u1 = u2; }
#undef CB_LOAD
    }
}

__device__ __forceinline__ void s5_precompute(const Frame& F, int item, const float* a_re, const float* a_im, const float* log_step, const float* b_re, const float* b_im,
                                              const float* c_re, const float* c_im, const float* dsk, bf16_t* Bt2, bf16_t* W1t, float* AL) {
    LAS float* L = (LAS float*)F.lds;
    LAS float* POWr = L; LAS float* POWi = L + 2112; LAS float* BBr = L + 4224; LAS float* BBi = BBr + 1024; LAS float* Cr = BBi + 1024; LAS float* Ci = Cr + 1024; LAS float* Kt = Ci + 1024;
    const int tid = F.tid, g = item >> 2, q = item & 3;
    const float dt = expf(log_step[g]);
    for (int idx = tid; idx < 64 * 33; idx += 512) { const int p = idx / 33, tau = idx - p * 33; const float ar = a_re[g * 64 + p] * dt, ai = a_im[g * 64 + p] * dt;
        const float mag = expf(ar * (float)tau); float sn, cs; sincosf(ai * (float)tau, &sn, &cs); POWr[idx] = mag * cs; POWi[idx] = mag * sn; }
    for (int idx = tid; idx < 1024; idx += 512) { const int p = idx >> 4, c = idx & 15; const float are = a_re[g * 64 + p], aim = a_im[g * 64 + p];
        const float mag = expf(are * dt); float sn, cs; sincosf(aim * dt, &sn, &cs); const float abr = mag * cs, abi = mag * sn, den = are * are + aim * aim, nr = abr - 1.0f;
        const float fre = (nr * are + abi * aim) / den, fim = (abi * are - nr * aim) / den; const float br = b_re[(size_t)(g * 64 + p) * 16 + c], bi = b_im[(size_t)(g * 64 + p) * 16 + c];
        BBr[idx] = fre * br - fim * bi; BBi[idx] = fre * bi + fim * br; }
    for (int idx = tid; idx < 1024; idx += 512) { const int cp = idx >> 6, p = idx & 63; Cr[idx] = c_re[(size_t)(g * 16 + cp) * 64 + p]; Ci[idx] = c_im[(size_t)(g * 16 + cp) * 64 + p]; }
    __syncthreads();
    for (int idx = tid; idx < 2048; idx += 512) { const int tau = idx >> 6, cq = (idx >> 4) & 3, cp = 4 * q + cq, c = idx & 15; float sum = 0.f;
        for (int p = 0; p < 64; ++p) { const float pr = POWr[p * 33 + tau], pi = POWi[p * 33 + tau], br = BBr[p * 16 + c], bi = BBi[p * 16 + c];
            sum += Cr[cp * 64 + p] * (pr * br - pi * bi) - Ci[cp * 64 + p] * (pr * bi + pi * br); }
        if (tau == 0 && cp == c) sum += dsk[g * 16 + c];
        Kt[idx] = sum; }
    __syncthreads();
    for (int qq = tid; qq < 128 * 80; qq += 512) { const int rl = qq / 80, cc = qq - rl * 80, t = rl >> 2, cq = rl & 3, cp = 4 * q + cq, row = t * 16 + cp; float v[8];
        if (cc < 64) { const int s = cc >> 1, c0 = (cc & 1) * 8;
#pragma unroll
            for (int j = 0; j < 8; ++j) v[j] = (s <= t) ? Kt[(t - s) * 64 + cq * 16 + c0 + j] : 0.f;
        } else { const int p0 = (cc - 64) * 4;
#pragma unroll
            for (int j = 0; j < 8; ++j) { const int p = p0 + (j >> 1); const float pr = POWr[p * 33 + t + 1], pi = POWi[p * 33 + t + 1], cr = Cr[cp * 64 + p], ci = Ci[cp * 64 + p];
                v[j] = (j & 1) ? -(cr * pi + ci * pr) : (cr * pr - ci * pi); } }
        u32x4 w; w.x = cvt_pk_bf16(v[0], v[1]); w.y = cvt_pk_bf16(v[2], v[3]); w.z = cvt_pk_bf16(v[4], v[5]); w.w = cvt_pk_bf16(v[6], v[7]);
        *(u32x4*)(Bt2 + ((size_t)g * 512 + row) * S5K + cc * 8) = w; }
    for (int qq = tid; qq < 64 * 64; qq += 512) { const int rl = qq >> 6, cc = qq & 63, s = cc >> 1, c0 = (cc & 1) * 8; float v[8];
        int row;
        if (rl < 32) { row = 32 * q + rl; const int p = row >> 1, im = row & 1; const float pr = POWr[p * 33 + 31 - s], pi = POWi[p * 33 + 31 - s];
#pragma unroll
            for (int j = 0; j < 8; ++j) { const float br = BBr[p * 16 + c0 + j], bi = BBi[p * 16 + c0 + j]; v[j] = im ? (pr * bi + pi * br) : (pr * br - pi * bi); }
        } else { row = 128 + 32 * q + (rl - 32);
#pragma unroll
            for (int j = 0; j < 8; ++j) v[j] = 0.f; }
        u32x4 w; w.x = cvt_pk_bf16(v[0], v[1]); w.y = cvt_pk_bf16(v[2], v[3]); w.z = cvt_pk_bf16(v[4], v[5]); w.w = cvt_pk_bf16(v[6], v[7]);
        *(u32x4*)(W1t + ((size_t)g * 256 + row) * 512 + cc * 8) = w; }
    if (q == 0 && tid < 64) { AL[(g * 64 + tid) * 2] = POWr[tid * 33 + 32]; AL[(g * 64 + tid) * 2 + 1] = POWi[tid * 33 + 32]; }
    __syncthreads();
}
__device__ __forceinline__ void s5_scan(const Frame& F, const float* S, const float* AL, bf16_t* HG) {
    const int gw = F.bx * 8 + F.wave, NGW = F.G * 8, p = F.lane;
    for (int item = gw; item < SG * NB; item += NGW) { const int g = item >> 4, b = item & 15;
        const float ar = AL[(g * 64 + p) * 2], ai = AL[(g * 64 + p) * 2 + 1];
        const size_t row0 = (size_t)g * S5ROWS + b * NCHUNK;
        float xr = 0.f, xi = 0.f;
        f32x2 nv[16];
#pragma unroll
        for (int k = 0; k < 16; ++k) nv[k] = *(const f32x2*)(S + (row0 + k) * 128 + 2 * p);
        for (int c0 = 0; c0 < NCHUNK; c0 += 16) { f32x2 sv[16];
#pragma unroll
            for (int k = 0; k < 16; ++k) sv[k] = nv[k];
            if (c0 + 16 < NCHUNK) {
#pragma unroll
                for (int k = 0; k < 16; ++k) nv[k] = *(const f32x2*)(S + (row0 + c0 + 16 + k) * 128 + 2 * p); }
#pragma unroll
            for (int k = 0; k < 16; ++k) { *(unsigned*)(HG + (row0 + c0 + k) * S5K + 512 + 2 * p) = cvt_pk_bf16(xr, xi);
                const float nr = ar * xr - ai * xi + sv[k].x, ni = ar * xi + ai * xr + sv[k].y; xr = nr; xi = ni; } }
    }
}

template <bool Q8> __device__ __forceinline__ void norm_router(const Frame& F, const bf16_t* x, const float* ng, const float* mod_sh, const float* mod_sc, bf16_t* H,
                                            const float* rw, const float* rb, unsigned* gcnt, int* LIST, float* GATEW, float* SAL, float* SHL, const float* SB, int dry) {
    LAS int* lcnt = (LAS int*)F.lds;
    LAS int* lbase = lcnt + 16;
    LAS int* te = lbase + 16;
    LAS int* tp = te + 512;
    LAS float* tg = (LAS float*)(tp + 512);
    LAS float* tsa = tg + 512;
    LAS float* ths = tsa + 256;
    LAS float* tlg = ths + 256;
    const int lane = F.lane, wave = F.wave, tid = F.tid;
    f32x2 rwv[4][4][4];
#pragma unroll
    for (int j = 0; j < 4; ++j)
#pragma unroll
        for (int i = 0; i < 4; ++i) { const int k = 256 * j + 4 * lane + i; const f32x4 a = *(const f32x4*)(rw + (size_t)k * 8), c = *(const f32x4*)(rw + (size_t)k * 8 + 4);
            rwv[j][i][0] = (f32x2){a.x, a.y}; rwv[j][i][1] = (f32x2){a.z, a.w}; rwv[j][i][2] = (f32x2){c.x, c.y}; rwv[j][i][3] = (f32x2){c.z, c.w}; }
    float rbv[8];
#pragma unroll
    for (int e = 0; e < 8; ++e) rbv[e] = rb[e];
    for (int blk = F.bx; blk < NTOK / 256; blk += F.G) {
        if (tid < 16) lcnt[tid] = 0;
        __syncthreads();
        const int b = blk >> 4;
        f32x4 gs[4], sh[4];
#pragma unroll
        for (int j = 0; j < 4; ++j) { const int col = 256 * j + 4 * lane; const f32x4 g4 = *(const f32x4*)(ng + col), s4 = *(const f32x4*)(mod_sc + (size_t)b * 6144 + col);
            gs[j] = g4 * (s4 + 1.0f); sh[j] = *(const f32x4*)(mod_sh + (size_t)b * 6144 + col); }
        f32x4 nx[4];
#pragma unroll
        for (int j = 0; j < 4; ++j) nx[j] = xb_ld4(x + ((size_t)blk * 256 + wave * 32) * DM + 256 * j + 4 * lane);
#pragma unroll 2
        for (int rr = 0; rr < 32; ++rr) { const int lt = wave * 32 + rr; const size_t row = (size_t)blk * 256 + lt;
            f32x4 v[4]; float ss = 0.f;
#pragma unroll
            for (int j = 0; j < 4; ++j) { v[j] = nx[j]; ss += (v[j].x * v[j].x + v[j].y * v[j].y) + (v[j].z * v[j].z + v[j].w * v[j].w); }
            if (rr + 1 < 32) {
#pragma unroll
                for (int j = 0; j < 4; ++j) nx[j] = xb_ld4(x + (row + 1) * DM + 256 * j + 4 * lane); }
            const float rstd = fast_rsq(wave_sum(ss) * (1.0f / DM) + RMS_EPS);
            u32x2* o8 = (u32x2*)(H + row * DM) + lane; float lg[8]; f32x2 lg2[4]; float amax = 0.f, hn2 = 0.f;
#pragma unroll
            for (int e = 0; e < 4; ++e) lg2[e] = (f32x2){0.f, 0.f};
#pragma unroll
            for (int j = 0; j < 4; ++j) { const f32x4 h = v[j] * rstd * gs[j] + sh[j]; v[j] = h;
                if constexpr (!Q8) { u32x2 w; w.x = cvt_pk_bf16(h.x, h.y); w.y = cvt_pk_bf16(h.z, h.w); o8[64 * j] = w; }
                else { amax = amax3(amax3(amax, h.x, h.y), h.z, h.w); hn2 += (h.x * h.x + h.y * h.y) + (h.z * h.z + h.w * h.w); }
#pragma unroll
                for (int e = 0; e < 4; ++e) lg2[e] += rwv[j][0][e] * h.x + rwv[j][1][e] * h.y + rwv[j][2][e] * h.z + rwv[j][3][e] * h.w; }
            if constexpr (Q8) {
                amax = wave_max(amax);
                const float qs = amax > 0.f ? 127.0f * fast_rcp(amax) : 0.f; unsigned* q8 = (unsigned*)((signed char*)H + row * DM) + lane;
#pragma unroll
                for (int j = 0; j < 4; ++j) q8[64 * j] = q8pack(v[j].x, v[j].y, v[j].z, v[j].w, qs);
                hn2 = wave_sum(hn2);
                if (lane == 0) { tsa[lt] = amax * (1.0f / 127.0f); ths[lt] = hn2; } }
#pragma unroll
            for (int e = 0; e < 8; ++e) lg[e] = 0.f;
            {
              float t0 = swap16add(swap32add(lg2[0].x, lg2[0].y), swap32add(lg2[1].x, lg2[1].y)), t1 = swap16add(swap32add(lg2[2].x, lg2[2].y), swap32add(lg2[3].x, lg2[3].y));
              t0 = row_sum(t0); t1 = row_sum(t1);
              if ((lane & 15) == 0) { const int q = lane >> 4, e0 = ((q & 1) << 1) | (q >> 1); tlg[lt * 8 + e0] = t0; tlg[lt * 8 + 4 + e0] = t1; } }
        }
        LDS_WAIT();
        if (lane < 32) { const int lt = wave * 32 + lane; const f32x4 la = *(const LAS f32x4*)(tlg + lt * 8), lb = *(const LAS f32x4*)(tlg + lt * 8 + 4);
            const float mylg[8] = {la.x + rbv[0], la.y + rbv[1], la.z + rbv[2], la.w + rbv[3], lb.x + rbv[4], lb.y + rbv[5], lb.z + rbv[6], lb.w + rbv[7]}; float b1 = mylg[0], b2 = -3.0e38f; int i1 = 0, i2 = 0;
#pragma unroll
            for (int e = 1; e < 8; ++e) { if (mylg[e] > b1) { b2 = b1; i2 = i1; b1 = mylg[e]; i1 = e; } else if (mylg[e] > b2) { b2 = mylg[e]; i2 = e; } }
            const float g1 = 1.0f / (1.0f + __expf(b2 - b1));
            te[lt * 2] = i1; te[lt * 2 + 1] = i2; tg[lt * 2] = g1; tg[lt * 2 + 1] = 1.0f - g1;
            tp[lt * 2] = __hip_atomic_fetch_add(lcnt + i1, 1, __ATOMIC_RELAXED, __HIP_MEMORY_SCOPE_WORKGROUP);
            tp[lt * 2 + 1] = __hip_atomic_fetch_add(lcnt + 8 + i2, 1, __ATOMIC_RELAXED, __HIP_MEMORY_SCOPE_WORKGROUP);
            }
        __syncthreads();
        if (tid < 16) lbase[tid] = dry ? 0 : (int)__hip_atomic_fetch_add(gcnt + tid, (unsigned)lcnt[tid], __ATOMIC_RELAXED, __HIP_MEMORY_SCOPE_AGENT);
        __syncthreads();
        if (tid < 512 && !dry) { const int lt = tid >> 1, s = tid & 1; const int e = te[lt * 2 + s]; const int pos = lbase[s * 8 + e] + tp[lt * 2 + s];
            LIST[(size_t)(s * 8 + e) * NTOK + pos] = blk * 256 + lt; GATEW[(size_t)(s * 8 + e) * NTOK + pos] = tg[lt * 2 + s];
            if constexpr (Q8) {
                const float rg = SB[2 * e] * (127.0f / WQ), ru = SB[2 * e + 1] * (127.0f / WQ);
                const float shl = fmaxf(QH * ths[lt] * rg * ru, 1e-20f) * (1.0f / 127.0f), sg = tsa[lt] * SB[2 * e], su = tsa[lt] * SB[2 * e + 1];
                SHL[(size_t)(s * 8 + e) * NTOK + pos] = shl; WSP<f32x2>(F, WS_REC)[(size_t)(s * 8 + e) * NTOK + pos] = (f32x2){__int_as_float(blk * 256 + lt), tg[lt * 2 + s] * shl}; ((f32x2*)SAL)[(size_t)(s * 8 + e) * NTOK + pos] = (f32x2){-sg * LOG2E, sg * su / shl}; } }
        __syncthreads();
    }
}

__device__ __forceinline__ void mod_phase(const Frame& F, const float* c, const float* mod_w, const float* mod_b, float* MOD, bf16_t* GATEB) {
    if (F.bx >= 4 * 48) return;
    LAS float* cond = (LAS float*)F.lds; LAS float* red = cond + 16384;
    const int tid = F.tid;
    for (int idx = tid; idx < 16384; idx += 512) { const int b = idx >> 10, k = idx & 1023; cond[k * 16 + b] = silu_f(c[idx]); }
    __syncthreads();
    const int kq = tid >> 7, col = tid & 127;
    for (int item = F.bx; item < 4 * 48; item += F.G) { const int l = item / 48, col0 = (item - l * 48) * 128;
        f32x2 acc[8];
#pragma unroll
        for (int b = 0; b < 8; ++b) acc[b] = (f32x2){0.f, 0.f};
        const float* wp = mod_w + ((size_t)l * DM + kq * 256) * 6144 + col0 + col;
        const LAS float* cq = cond + kq * 256 * 16;
        for (int k0 = 0; k0 < 256; k0 += 16) { float w[16];
#pragma unroll
            for (int i = 0; i < 16; ++i) w[i] = wp[(size_t)(k0 + i) * 6144];
#pragma unroll
            for (int i = 0; i < 16; ++i) { const LAS f32x4* cp = (const LAS f32x4*)(cq + (k0 + i) * 16); const f32x4 c0 = cp[0], c1 = cp[1], c2 = cp[2], c3 = cp[3]; const f32x2 w2 = (f32x2){w[i], w[i]};
                acc[0] += (f32x2){c0.x, c0.y} * w2; acc[1] += (f32x2){c0.z, c0.w} * w2; acc[2] += (f32x2){c1.x, c1.y} * w2; acc[3] += (f32x2){c1.z, c1.w} * w2;
                acc[4] += (f32x2){c2.x, c2.y} * w2; acc[5] += (f32x2){c2.z, c2.w} * w2; acc[6] += (f32x2){c3.x, c3.y} * w2; acc[7] += (f32x2){c3.z, c3.w} * w2; } }
#pragma unroll
        for (int b = 0; b < 8; ++b) { red[(kq * 16 + 2 * b) * 128 + col] = acc[b].x; red[(kq * 16 + 2 * b + 1) * 128 + col] = acc[b].y; }
        __syncthreads();
#pragma unroll
        for (int o = 0; o < 4; ++o) { const int idx = tid + 512 * o, b = idx >> 7, cc = idx & 127;
            float sum = mod_b[(size_t)l * 6144 + col0 + cc];
#pragma unroll
            for (int q = 0; q < 4; ++q) sum += red[(q * 16 + b) * 128 + cc];
            MOD[((size_t)l * 16 + b) * 6144 + col0 + cc] = sum;
            if (col0 >= 5 * DM) GATEB[((size_t)l * 16 + b) * 1024 + (col0 - 5 * DM) + cc] = (bf16_t)(cvt_pk_bf16(sum, sum) & 0xffffu); }
        __syncthreads();
    }
}
__device__ __forceinline__ void rope_phase(const Frame& F, const int* positions, float* ROPE) {
    for (int idx = F.bx * 512 + F.tid; idx < NTOK * 8; idx += F.G * 512) { const int tok = idx >> 3, f = idx & 7;
        const float inv = exp2f(-(float)f * 0.125f * 18.931568569324174f);
        const float ang = (float)positions[tok] * inv; float sn, cs; sincosf(ang, &sn, &cs);
        ROPE[(size_t)tok * 16 + f] = cs; ROPE[(size_t)tok * 16 + 8 + f] = sn; }
}
__device__ __forceinline__ void conv_item_i8(const float* W, int K, int N, signed char* Wt, int row_off, LAS float* scr, int item, int lane, float qs, int mode) {
    const int nblk = N / 64, kb = item / nblk, nb = item - kb * nblk, k0 = 64 * kb, n0 = 64 * nb;
    const int kr = lane >> 4, nq = lane & 15;
    f32x4 v[16];
    const float* src = W + (size_t)(k0 + kr) * N + n0 + 4 * nq;
#pragma unroll
    for (int i = 0; i < 16; ++i) v[i] = *(const f32x4*)(src + (size_t)(4 * i) * N);
    int nqd = nq; if (mode == 1 && n0 < 1024) nqd = (nq == 1) ? 2 : ((nq == 2) ? 1 : nq);
#pragma unroll
    for (int i = 0; i < 16; ++i) { const int kk = 4 * i + kr; *(LAS f32x4*)(scr + kk * 64 + ((4 * nqd) ^ ((kk >> 3) << 3))) = v[i]; }
    LDS_WAIT(); asm volatile("" ::: "memory");
    const int c = lane & 3;
#pragma unroll
    for (int j = 0; j < 4; ++j) { const int n = (lane >> 2) + 16 * j;
        const LAS float* s0 = scr + (16 * c) * 64 + (n ^ ((2 * c) << 3)); const LAS float* s1 = scr + (16 * c + 8) * 64 + (n ^ ((2 * c + 1) << 3));
        u32x4 o; o.x = q8pack(s0[0 * 64], s0[1 * 64], s0[2 * 64], s0[3 * 64], qs); o.y = q8pack(s0[4 * 64], s0[5 * 64], s0[6 * 64], s0[7 * 64], qs);
        o.z = q8pack(s1[0 * 64], s1[1 * 64], s1[2 * 64], s1[3 * 64], qs); o.w = q8pack(s1[4 * 64], s1[5 * 64], s1[6 * 64], s1[7 * 64], qs);
        *(u32x4*)(Wt + (size_t)(row_off + n0 + n) * K + k0 + 16 * c) = o; }
    LDS_WAIT(); asm volatile("" ::: "memory");
}
__device__ __forceinline__ int conv_run_i8(const Frame& F, const float* W, signed char* Wt, int K, int N, int row_off, int base, LAS float* scr, float* sb_out, int mode = 0) {
    const int gw = F.bx * 8 + F.wave, NGW = F.G * 8, nitems = (K / 64) * (N / 64);
    float ss = 0.f;
#pragma unroll
    for (int i = 0; i < 16; ++i) { const f32x4 t = *(const f32x4*)(W + (size_t)(i * 64 + F.lane) * 4); ss += (t.x * t.x + t.y * t.y) + (t.z * t.z + t.w * t.w); }
    const float range = WQ * sqrtf(wave_sum(ss) * (1.0f / 4096.0f)) + 1e-30f, qs = 127.0f / range;
    if (gw == 0 && F.lane == 0) *sb_out = range * (1.0f / 127.0f);
    int first = (gw - base) % NGW; if (first < 0) first += NGW;
    for (int it = first; it < nitems; it += NGW) conv_item_i8(W, K, N, Wt, row_off, scr, it, F.lane, qs, mode);
    return base + nitems;
}

__device__ __forceinline__ int conv_run(const Frame& F, const float* W, bf16_t* Wt, int K, int N, int ldt, int row_off, int mode, int base, LAS float* scr) {
    const int gw = F.bx * 8 + F.wave, NGW = F.G * 8, nitems = (K / 64) * (N / 64);
    int first = (gw - base) % NGW; if (first < 0) first += NGW;
    for (int it = first; it < nitems; it += NGW) conv_item(W, K, N, Wt, ldt, row_off, scr, it, F.lane, mode);
    return base + nitems;
}

#ifndef PHASE_MASK
#define PHASE_MASK 0xffffffffu
#endif
constexpr unsigned PH = PHASE_MASK;
#define PHON(k) ((PH >> (k)) & 1u)
#ifndef DUP_MASK
#define DUP_MASK 0u
#endif
#define DUPON(k) (((DUP_MASK) >> (k)) & 1u)
#ifndef I8_ALL
#define I8_ALL 1
#endif
#ifndef DRY17
#define DRY17 0
#endif
struct Args { const void* in[29]; float* out; unsigned char* ws; int pad0, pad1; };

__device__ __forceinline__ void grid_bar(const Frame& F) {
    XcdBarrier b; b.bar = WSP<unsigned>(F, WS_CTL) + CW_BAR; b.x = xb_xcc_id(); b.st = (volatile LAS unsigned*)(F.lds - RING_OFF + MISC_OFF) + 8;
    xcd_barrier(b);
}

__global__ void __launch_bounds__(512, 2) trunk_fwd(Args args) {
    extern __shared__ __attribute__((aligned(16))) unsigned char lds_raw[];
    Frame F; F.lds = (LAS unsigned char*)lds_raw + RING_OFF; F.tid = threadIdx.x; F.lane = F.tid & 63; F.wave = __builtin_amdgcn_readfirstlane(F.tid >> 6); F.G = gridDim.x; F.bx = blockIdx.x;
    const Frame& F0 = F;
    for (int u = F.tid; u < LDSCTL_BYTES / 4; u += 512) ((LAS unsigned*)((LAS unsigned char*)lds_raw + LDSCTL_OFF))[u] = 0u;
    __syncthreads();
    if (F.tid < 31) { const void* p = (F.tid < 29) ? args.in[F.tid] : (F.tid == 29 ? (const void*)args.out : (const void*)args.ws);
        const unsigned long long v = (unsigned long long)p; LAS unsigned* t = (LAS unsigned*)((LAS unsigned char*)lds_raw + PTAB_OFF) + 2 * F.tid; t[0] = (unsigned)v; t[1] = (unsigned)(v >> 32); }
    __syncthreads();
    (void)xcd_barrier_post(WSP<unsigned>(F, WS_CTL) + CW_BAR, (volatile LAS unsigned*)((LAS unsigned char*)lds_raw + MISC_OFF) + 8);
#define GRID_BAR() grid_bar(F)
#if DUP_MASK
#define PHASE(k) if (PHON(k)) for (int rep_ = DUPON(k) ? 0 : 1; rep_ < 2; ++rep_) if (const int dry_ = opaque_i(rep_ == 0 ? 1 : 0); true) if (const Frame F = fresh(F0); true)
#else
#define PHASE(k) if (PHON(k)) if (constexpr int dry_ = 0; true) if (const Frame F = fresh(F0); true)
#endif
    LAS float* scr = (LAS float*)(F.lds + F.wave * 16384);

    PHASE(0) mod_phase(F, PT<const float>(F, P_C), PT<const float>(F, P_MODW), PT<const float>(F, P_MODB), WSP<float>(F, WS_MOD), WSP<bf16_t>(F, WS_GATEB));
    PHASE(0) rope_phase(F, PT<const int>(F, P_POS), WSP<float>(F, WS_ROPE));
    PHASE(1) {
        int base = 0;
        for (int i = 0; i < 2; ++i) {
            base = conv_run_i8(F, PT<const float>(F, P_WIN) + (size_t)i * DM * NWIN, WSP<signed char>(F, WS_WIN) + (size_t)i * NWIN * DM, DM, NWIN, 0, base, scr, WSP<float>(F, WS_SB) + SBF_OFF + 8 + i, 1);
            base = conv_run(F, PT<const float>(F, P_WOUT) + (size_t)i * DM * DM, WSP<bf16_t>(F, WS_WOUT) + (size_t)i * DM * DM, DM, DM, DM, 0, 2, base, scr);
            base = conv_run_i8(F, PT<const float>(F, P_FG) + (size_t)i * DM * DFF, WSP<signed char>(F, WS_WGU) + (size_t)i * 2 * DFF * DM, DM, DFF, 0, base, scr, WSP<float>(F, WS_SB) + SBF_OFF + 3 * i);
            base = conv_run_i8(F, PT<const float>(F, P_FU) + (size_t)i * DM * DFF, WSP<signed char>(F, WS_WGU) + (size_t)i * 2 * DFF * DM, DM, DFF, DFF, base, scr, WSP<float>(F, WS_SB) + SBF_OFF + 3 * i + 1);
            base = conv_run_i8(F, PT<const float>(F, P_FD) + (size_t)i * DFF * DM, WSP<signed char>(F, WS_WDN) + (size_t)i * DM * DFF, DFF, DM, 0, base, scr, WSP<float>(F, WS_SB) + SBF_OFF + 3 * i + 2);
            base = conv_run(F, PT<const float>(F, P_GLUW) + (size_t)i * DM * 2 * DM, WSP<bf16_t>(F, WS_WGLU) + (size_t)i * 2 * DM * DM, DM, 2 * DM, DM, 0, 0, base, scr);
        }
    }
    GRID_BAR();

    for (int li = 0; li < 2; ++li) {
        {
            const int L = 2 * li; const int modoff = L * 16 * 6144;
            PHASE(2) { const float* modL = WSP<const float>(F, WS_MOD) + modoff;
                if (li == 0) norm_plain<2, true>(F, PT<const float>(F, P_X), PT<const float>(F, P_NMIX) + L * DM, modL + 0 * DM, modL + 1 * DM, WSP<bf16_t>(F, WS_H), nullptr, WSP<float>(F, WS_SHT), nullptr);
                else norm_plain<2, false>(F, WSP<const bf16_t>(F, WS_XB), PT<const float>(F, P_NMIX) + L * DM, modL + 0 * DM, modL + 1 * DM, WSP<bf16_t>(F, WS_H), nullptr, WSP<float>(F, WS_SHT), nullptr); }
            GRID_BAR();
            PHASE(3) { SchedWin S{F.G, F.bx}; EpiWin<true> E{F, li};
              pg8::gemm_phase<EpiWin<true>, SchedWin, false, DM / 2, DM / 2, DM / 2, true>(F.lds, WSP<const bf16_t>(F, WS_H), (const bf16_t*)(WSP<const signed char>(F, WS_WIN) + (size_t)li * NWIN * DM), S, E, nullptr); }
            GRID_BAR();
            PHASE(4) { unsigned char* big = WSP<unsigned char>(F, WS_BIG);
                attn_phase(F, (const bf16_t*)(big + BG_Q), (const bf16_t*)(big + BG_K), (const bf16_t*)(big + BG_V), (bf16_t*)(big + BG_OB), (float*)(big + BG_LSE)); }
            GRID_BAR();
            PHASE(5) { unsigned char* big = WSP<unsigned char>(F, WS_BIG);
                combine_phase(F, (const bf16_t*)(big + BG_OB), (const float*)(big + BG_LSE), (const bf16_t*)(big + BG_BG), (const bf16_t*)(big + BG_U), PT<const float>(F, P_CONVW) + (size_t)li * 3 * CW, WSP<bf16_t>(F, WS_H)); }
            GRID_BAR();
            PHASE(6) { SchedPlain<NTOK / 256, DM / 256> S{F.G, F.bx}; EpiRes E{F, li == 0 ? 1 : 0, modoff + 2 * DM, dry_};
              pg8::gemm_phase<EpiRes, SchedPlain<NTOK / 256, DM / 256>, false, DM, DM, DM>(F.lds, WSP<const bf16_t>(F, WS_H), WSP<const bf16_t>(F, WS_WOUT) + (size_t)li * DM * DM, S, E, nullptr); }
            GRID_BAR();
            PHASE(2) { const float* modL = WSP<const float>(F, WS_MOD) + modoff;
                norm_plain<1, false>(F, WSP<const bf16_t>(F, WS_XB), PT<const float>(F, P_NFFN) + L * DM, modL + 3 * DM, modL + 4 * DM, WSP<bf16_t>(F, WS_H), WSP<float>(F, WS_SCT), WSP<float>(F, WS_SHT), WSP<const float>(F, WS_SB) + SBF_OFF + 3 * li); }
            GRID_BAR();
            PHASE(7) { SchedPair<NTOK / 256, DFF / 128, DFF> S{F.G, F.bx}; EpiActI8<DFF, false, true> E{F, 0, li, 0};
              pg8::gemm_phase<EpiActI8<DFF, false, true>, SchedPair<NTOK / 256, DFF / 128, DFF>, false, DM / 2, DM / 2, DM / 2, true>(F.lds, WSP<const bf16_t>(F, WS_H), (const bf16_t*)(WSP<const signed char>(F, WS_WGU) + (size_t)li * 2 * DFF * DM), S, E, nullptr); }
            GRID_BAR();
            PHASE(8) { SchedPlain<NTOK / 256, DM / 256> S{F.G, F.bx}; EpiResI8 E{F, modoff + 5 * DM, li, dry_};
              pg8::gemm_phase<EpiResI8, SchedPlain<NTOK / 256, DM / 256>, false, DFF / 2, DFF / 2, DFF / 2, true>(F.lds, WSP<const bf16_t>(F, WS_BIG + BG_HID), (const bf16_t*)(WSP<const signed char>(F, WS_WDN) + (size_t)li * DM * DFF), S, E, nullptr); }
            GRID_BAR();
        }
        {
            const int L = 2 * li + 1; const int modoff = L * 16 * 6144;
            PHASE(9) for (int it = F.bx; it < 4 * SG; it += F.G)
                s5_precompute(F, it, PT<const float>(F, P_ARE) + (size_t)li * SG * SP, PT<const float>(F, P_AIM) + (size_t)li * SG * SP, PT<const float>(F, P_LSTEP) + (size_t)li * SG,
                              PT<const float>(F, P_BRE) + (size_t)li * SG * SP * SC, PT<const float>(F, P_BIM) + (size_t)li * SG * SP * SC,
                              PT<const float>(F, P_CRE) + (size_t)li * SG * SC * SP, PT<const float>(F, P_CIM) + (size_t)li * SG * SC * SP, PT<const float>(F, P_SD) + (size_t)li * DM,
                              WSP<bf16_t>(F, WS_BIG + BG_BT2), WSP<bf16_t>(F, WS_BIG + BG_W1T), WSP<float>(F, WS_AL));
            PHASE(10) {
                int base = 0;
                for (int e = 0; e < NE; ++e) {
                    if (I8_ALL || li == 1) {
                        base = conv_run_i8(F, PT<const float>(F, P_MG) + ((size_t)li * NE + e) * DM * DFE, WSP<signed char>(F, WS_WMGU) + (size_t)e * 2 * DFE * DM, DM, DFE, 0, base, scr, WSP<float>(F, WS_SB) + 2 * e);
                        base = conv_run_i8(F, PT<const float>(F, P_MU) + ((size_t)li * NE + e) * DM * DFE, WSP<signed char>(F, WS_WMGU) + (size_t)e * 2 * DFE * DM, DM, DFE, DFE, base, scr, WSP<float>(F, WS_SB) + 2 * e + 1);
                    } else {
                    base = conv_run(F, PT<const float>(F, P_MG) + ((size_t)li * NE + e) * DM * DFE, WSP<bf16_t>(F, WS_WMGU) + (size_t)e * 2 * DFE * DM, DM, DFE, DM, 0, 0, base, scr);
                    base = conv_run(F, PT<const float>(F, P_MU) + ((size_t)li * NE + e) * DM * DFE, WSP<bf16_t>(F, WS_WMGU) + (size_t)e * 2 * DFE * DM, DM, DFE, DM, DFE, 0, base, scr); }
                    base = conv_run_i8(F, PT<const float>(F, P_MD) + ((size_t)li * NE + e) * DFE * DM, WSP<signed char>(F, WS_WMDN) + (size_t)e * DM * DFE, DFE, DM, 0, base, scr, WSP<float>(F, WS_SB) + 16 + e);
                }
            }
            PHASE(11) { const float* modL = WSP<const float>(F, WS_MOD) + modoff;
                norm_s5(F, WSP<const bf16_t>(F, WS_XB), PT<const float>(F, P_NMIX) + L * DM, modL + 0 * DM, modL + 1 * DM, WSP<bf16_t>(F, WS_BIG + BG_HG)); }
            GRID_BAR();
            PHASE(12) { SchedS5A S{F.G, F.bx}; EpiS5A E{F};
              pg8::gemm_phase<EpiS5A, SchedS5A, false, S5K, 512, 512>(F.lds, WSP<const bf16_t>(F, WS_BIG + BG_HG), WSP<const bf16_t>(F, WS_BIG + BG_W1T), S, E, nullptr); }
            GRID_BAR();
            PHASE(13) s5_scan(F, WSP<const float>(F, WS_BIG + BG_S), WSP<const float>(F, WS_AL), WSP<bf16_t>(F, WS_BIG + BG_HG));
            GRID_BAR();
            PHASE(14) { SchedS5B S{F.G, F.bx}; EpiS5B E{F};
              pg8::gemm_phase<EpiS5B, SchedS5B, false, S5K, S5K, S5K>(F.lds, WSP<const bf16_t>(F, WS_BIG + BG_HG), WSP<const bf16_t>(F, WS_BIG + BG_BT2), S, E, nullptr); }
            GRID_BAR();
            PHASE(15) { SchedPair<NTOK / 256, DM / 128, DM> S{F.G, F.bx}; EpiGlu E{F, modoff + 2 * DM, li, dry_};
              pg8::gemm_phase<EpiGlu, SchedPair<NTOK / 256, DM / 128, DM>, false, DM, DM, DM>(F.lds, WSP<const bf16_t>(F, WS_H), WSP<const bf16_t>(F, WS_WGLU) + (size_t)li * 2 * DM * DM, S, E, nullptr); }
            GRID_BAR();
            PHASE(16) { const float* modL = WSP<const float>(F, WS_MOD) + modoff;
                if (I8_ALL || li == 1) norm_router<true>(F, WSP<const bf16_t>(F, WS_XB), PT<const float>(F, P_NFFN) + L * DM, modL + 3 * DM, modL + 4 * DM, WSP<bf16_t>(F, WS_H), PT<const float>(F, P_RW) + (size_t)li * DM * NE, PT<const float>(F, P_RB) + (size_t)li * NE,
                            WSP<unsigned>(F, WS_CTL) + CW_MOECNT + li * 16, WSP<int>(F, WS_LIST), WSP<float>(F, WS_GATEW), WSP<float>(F, WS_SCL), WSP<float>(F, WS_SHL), WSP<const float>(F, WS_SB), dry_);
                else norm_router<false>(F, WSP<const bf16_t>(F, WS_XB), PT<const float>(F, P_NFFN) + L * DM, modL + 3 * DM, modL + 4 * DM, WSP<bf16_t>(F, WS_H), PT<const float>(F, P_RW) + (size_t)li * DM * NE, PT<const float>(F, P_RB) + (size_t)li * NE,
                            WSP<unsigned>(F, WS_CTL) + CW_MOECNT + li * 16, WSP<int>(F, WS_LIST), WSP<float>(F, WS_GATEW), WSP<float>(F, WS_SCL), WSP<float>(F, WS_SHL), WSP<const float>(F, WS_SB), dry_); }
            GRID_BAR();
            for (int slot = 0; slot < 2; ++slot) {
                PHASE(17) { const unsigned* gc = WSP<const unsigned>(F, WS_CTL) + CW_MOECNT + li * 16; int cc = F.bx;
                  if (slot == 1) { const int r8 = ((moe_tiles(gc) * (DM / 256)) % F.G) & ~7; cc = (F.bx + F.G - r8) % F.G; }
                  moe_table(F, gc + slot * 8); SchedMoe<DFE / 128, 0> S{F.G, cc, slot * 8 * NTOK}; EpiActI8<DFE, true, true> E{F, DRY17 ? dry_ : 0, li, slot};
                  pg8::gemm_phase<EpiActI8<DFE, true, true>, SchedMoe<DFE / 128, 0>, true, DM / 2, DM / 2, DM / 2, true>(F.lds, WSP<const bf16_t>(F, WS_H), WSP<const bf16_t>(F, WS_WMGU), S, E, WSP<const int>(F, WS_LIST)); }
                GRID_BAR();
                PHASE(18) { moe_table(F, WSP<const unsigned>(F, WS_CTL) + CW_MOECNT + li * 16 + slot * 8);
                  { SchedMoe<DM / 256, 1> S{F.G, F.bx, slot * 8 * NTOK}; EpiMoeDownI8<false> E{F, L, dry_};
                    pg8::gemm_phase<EpiMoeDownI8<false>, SchedMoe<DM / 256, 1>, false, DFE / 2, DFE / 2, DFE / 2, true>(F.lds, (const bf16_t*)(WSP<const signed char>(F, WS_BIG + BG_HID) + (size_t)slot * HID_SLOT), WSP<const bf16_t>(F, WS_WMDN), S, E, nullptr); }
                  { SchedMoe<DM / 256, 2> S{F.G, F.bx, slot * 8 * NTOK}; EpiMoeDownI8<true> E{F, L, dry_};
                    pg8::gemm_phase<EpiMoeDownI8<true>, SchedMoe<DM / 256, 2>, false, DFE / 2, DFE / 2, DFE / 2, true>(F.lds, (const bf16_t*)(WSP<const signed char>(F, WS_BIG + BG_HID) + (size_t)slot * HID_SLOT), WSP<const bf16_t>(F, WS_WMDN), S, E, nullptr); } }
                if (slot == 1) GRID_BAR();
            }
        }
    }
    PHASE(19) norm_final(F, WSP<const bf16_t>(F, WS_XB), PT<float>(F, P_OUT), PT<const float>(F, P_FNG));
}

extern "C" void kernel_launch(void* const* d_in, const int* in_sizes, int n_in, void* d_out, int out_size, void* d_ws, size_t ws_size, hipStream_t stream) {
    static int grid = 0;
    if (grid == 0) {
        if (n_in != 29 || in_sizes[0] != NTOK * DM || out_size != NTOK * DM || ws_size < WS_END) { fprintf(stderr, "kernel_launch: unexpected shapes (n_in %d, in0 %d, out %d, ws %zu < %zu)\n", n_in, n_in > 0 ? in_sizes[0] : -1, out_size, ws_size, (size_t)WS_END); grid = -1; return; }
        int dev = 0, cus = 0, per_cu = 0;
        if (hipGetDevice(&dev) != hipSuccess || hipDeviceGetAttribute(&cus, hipDeviceAttributeMultiprocessorCount, dev) != hipSuccess) { grid = -1; return; }
        if (hipFuncSetAttribute((const void*)trunk_fwd, hipFuncAttributeMaxDynamicSharedMemorySize, LDS_BYTES) != hipSuccess) { fprintf(stderr, "kernel_launch: hipFuncSetAttribute failed\n"); grid = -1; return; }
        if (hipOccupancyMaxActiveBlocksPerMultiprocessor(&per_cu, (const void*)trunk_fwd, 512, LDS_BYTES) != hipSuccess || per_cu < 1) fprintf(stderr, "kernel_launch: occupancy query says %d\n", per_cu);
        (void)hipGetLastError();
        grid = cus;
    }
    if (grid < 0) return;
    if (hipMemsetAsync((char*)d_ws + WS_CTL, 0, CTL_ZERO_BYTES, stream) != hipSuccess) return;
    Args a{};
    for (int i = 0; i < 29; ++i) a.in[i] = d_in[i];
    a.out = (float*)d_out; a.ws = (unsigned char*)d_ws; a.pad0 = 0; a.pad1 = 0;
    hipLaunchKernelGGL(trunk_fwd, dim3(grid), dim3(512), LDS_BYTES, stream, a);
}
```
